# Optimizing an MI355X kernel written in HIP

```python
import jax, jax.numpy as jnp
from jax import lax
import numpy as np

D_MODEL = 1024
BATCH = 16
SEQ = 256
DEPTH = 4
DEC_BATCH = 8
DEC_SEQ = 4096
PAST_LEN = 256

GRID_W = 64
N_MIXERS = 3
N_HEADS = 16
N_KV_HEADS = 4
HEAD_DIM = 64
GROUP = N_HEADS // N_KV_HEADS
ATTN_WIDTH = N_HEADS * HEAD_DIM
KV_WIDTH = N_KV_HEADS * HEAD_DIM
IN_WIDTH = 2 * ATTN_WIDTH + 2 * KV_WIDTH
Q_BLOCK = 128
WINDOW = 128
NA_MAX_ROWS = 8
NA_COLS = 16
ROPE_BASE = 10000.0
ROPE_PAIRS = HEAD_DIM // 4
EPS = 1e-6
NEG_INF = -1e30
N_B_LAYERS = (DEPTH + 1) // N_MIXERS
N_C_LAYERS = DEPTH // N_MIXERS

kernel_name = 'hybrid_dit_interleaved_attention_step'


def rms_norm(x, g):
    xf = x.astype(jnp.float32)
    y = xf * lax.rsqrt(jnp.mean(xf * xf, axis=-1, keepdims=True) + EPS)
    return (y * g.astype(jnp.float32)).astype(x.dtype)


def rope_tables(n):
    t = jnp.arange(n, dtype=jnp.int32)
    row = (t // GRID_W).astype(jnp.float32)
    col = (t % GRID_W).astype(jnp.float32)
    inv = ROPE_BASE ** (-jnp.arange(ROPE_PAIRS, dtype=jnp.float32) / ROPE_PAIRS)
    ang = jnp.concatenate([row[:, None] * inv, col[:, None] * inv], axis=-1)
    return jnp.cos(ang), jnp.sin(ang)


def apply_rope(x, cos, sin):
    half = HEAD_DIM // 2
    xf = x.astype(jnp.float32)
    x1, x2 = xf[..., :half], xf[..., half:]
    c_, s_ = cos[None, :, None, :], sin[None, :, None, :]
    return jnp.concatenate([x1 * c_ - x2 * s_, x2 * c_ + x1 * s_], axis=-1).astype(x.dtype)


def modulation(cond, w_mod_l, b_mod_l):
    m = jax.nn.silu(cond) @ w_mod_l + b_mod_l
    return jnp.split(m, 3, axis=-1)


def project(u, w_in_l, q_g, k_g):
    b_, t_ = u.shape[:2]
    p = u @ w_in_l
    q, k, v, z = jnp.split(p, [ATTN_WIDTH, ATTN_WIDTH + KV_WIDTH, ATTN_WIDTH + 2 * KV_WIDTH], axis=-1)
    q = rms_norm(q.reshape(b_, t_, N_HEADS, HEAD_DIM), q_g)
    k = rms_norm(k.reshape(b_, t_, N_KV_HEADS, HEAD_DIM), k_g)
    v = v.reshape(b_, t_, N_KV_HEADS, HEAD_DIM)
    return q, k, v, z


def softmax_with_sink(s, sink):
    if sink is None:
        return jax.nn.softmax(s, axis=-1)
    sk = sink.astype(jnp.float32)[None, :, :, None, None]
    m = jnp.maximum(jnp.max(s, axis=-1, keepdims=True), sk)
    p = jnp.exp(s - m)
    return p / (jnp.sum(p, axis=-1, keepdims=True) + jnp.exp(sk - m))


def to_blocks(q):
    b_, t_ = q.shape[:2]
    return q.reshape(b_, t_ // Q_BLOCK, Q_BLOCK, N_KV_HEADS, GROUP, HEAD_DIM).transpose(1, 0, 2, 3, 4, 5)


def from_blocks(o):
    nb, b_ = o.shape[:2]
    return o.transpose(1, 0, 2, 3, 4, 5).reshape(b_, nb * Q_BLOCK, ATTN_WIDTH)


def dense_attention(q, k, v, sink):
    scale = HEAD_DIM ** -0.5

    def block(qb):
        s = jnp.einsum('bqhgd,bkhd->bhgqk', qb * scale, k, preferred_element_type=jnp.float32)
        p = softmax_with_sink(s, sink).astype(v.dtype)
        return jnp.einsum('bhgqk,bkhd->bqhgd', p, v)

    return from_blocks(lax.map(block, to_blocks(q)))


def window_attention(q, k, v, k_ctx, v_ctx, sink):
    scale = HEAD_DIM ** -0.5
    n = q.shape[1]
    pad = ((0, 0), (WINDOW, WINDOW), (0, 0), (0, 0))
    kp, vp = jnp.pad(k, pad), jnp.pad(v, pad)
    band = Q_BLOCK + 2 * WINDOW
    kofs = jnp.arange(band) - WINDOW
    rel = kofs[None, :] - jnp.arange(Q_BLOCK)[:, None]

    def block(args):
        b, qb = args
        start = b * Q_BLOCK
        kb = lax.dynamic_slice_in_dim(kp, start, band, axis=1)
        vb = lax.dynamic_slice_in_dim(vp, start, band, axis=1)
        kpos = start + kofs
        valid = (jnp.abs(rel) <= WINDOW) & ((kpos >= 0) & (kpos < n))[None, :]
        qs = qb * scale
        s_loc = jnp.einsum('bqhgd,bkhd->bhgqk', qs, kb, preferred_element_type=jnp.float32)
        s_loc = jnp.where(valid, s_loc, NEG_INF)
        s_ctx = jnp.einsum('bqhgd,bkhd->bhgqk', qs, k_ctx, preferred_element_type=jnp.float32)
        p = softmax_with_sink(jnp.concatenate([s_loc, s_ctx], axis=-1), sink).astype(v.dtype)
        return (jnp.einsum('bhgqk,bkhd->bqhgd', p[..., :band], vb)
                + jnp.einsum('bhgqk,bkhd->bqhgd', p[..., band:], v_ctx))

    nb = n // Q_BLOCK
    return from_blocks(lax.map(block, (jnp.arange(nb), to_blocks(q))))


def neighborhood_attention(q, k, v, k_ctx, v_ctx, bias_table):
    scale = HEAD_DIM ** -0.5
    n = q.shape[1]
    rows = n // GRID_W
    wr = min(NA_MAX_ROWS, rows)
    wc = NA_COLS
    n_nb = wr * wc
    kr = jnp.arange(wr)
    kc = jnp.arange(wc)
    bias_h = bias_table.reshape(N_KV_HEADS, GROUP, 2 * NA_MAX_ROWS - 1, 2 * NA_COLS - 1)

    def block(args):
        b, qb = args
        t = b * Q_BLOCK + jnp.arange(Q_BLOCK)
        r, c_ = t // GRID_W, t % GRID_W
        rs = jnp.clip(r - wr // 2, 0, rows - wr)
        cs = jnp.clip(c_ - wc // 2, 0, GRID_W - wc)
        key_r = jnp.broadcast_to(rs[:, None, None] + kr[None, :, None], (Q_BLOCK, wr, wc))
        key_c = jnp.broadcast_to(cs[:, None, None] + kc[None, None, :], (Q_BLOCK, wr, wc))
        idx = (key_r * GRID_W + key_c).reshape(Q_BLOCK, n_nb)
        dr = (key_r - r[:, None, None] + NA_MAX_ROWS - 1).reshape(Q_BLOCK, n_nb)
        dc = (key_c - c_[:, None, None] + NA_COLS - 1).reshape(Q_BLOCK, n_nb)
        bias = bias_h[:, :, dr, dc].astype(jnp.float32)
        kb = jnp.take(k, idx, axis=1)
        vb = jnp.take(v, idx, axis=1)
        qs = qb * scale
        s_loc = jnp.einsum('bqhgd,bqkhd->bhgqk', qs, kb, preferred_element_type=jnp.float32) + bias[None]
        s_ctx = jnp.einsum('bqhgd,bkhd->bhgqk', qs, k_ctx, preferred_element_type=jnp.float32)
        p = jax.nn.softmax(jnp.concatenate([s_loc, s_ctx], axis=-1), axis=-1).astype(v.dtype)
        return (jnp.einsum('bhgqk,bqkhd->bqhgd', p[..., :n_nb], vb)
                + jnp.einsum('bhgqk,bkhd->bqhgd', p[..., n_nb:], v_ctx))

    nb = n // Q_BLOCK
    return from_blocks(lax.map(block, (jnp.arange(nb), to_blocks(q))))


def branch_out(o, z, w_out_l):
    return (o * jax.nn.silu(z)) @ w_out_l


def setup_inputs(seed: int = 0) -> dict:
    key = jax.random.key(seed)
    ks = jax.random.split(key, 17)
    f32 = jnp.float32
    nrm = lambda k_, shape: jax.random.normal(k_, shape, dtype=f32)
    return {
        'x_prompt': nrm(ks[0], (BATCH, SEQ, D_MODEL)),
        'x_sample': nrm(ks[1], (DEC_BATCH, DEC_SEQ, D_MODEL)),
        'cache_k': nrm(ks[2], (DEC_BATCH, DEPTH, PAST_LEN, N_KV_HEADS, HEAD_DIM)),
        'cache_v': nrm(ks[3], (DEC_BATCH, DEPTH, PAST_LEN, N_KV_HEADS, HEAD_DIM)),
        'c': nrm(ks[4], (DEC_BATCH, D_MODEL)),
        'c_ctx': nrm(ks[5], (D_MODEL,)),
        'w_mod': nrm(ks[6], (DEPTH, D_MODEL, 3 * D_MODEL)) * (0.5 * D_MODEL ** -0.5),
        'b_mod': nrm(ks[7], (DEPTH, 3 * D_MODEL)) * 0.02,
        'norm_pre': 1.0 + 0.05 * nrm(ks[8], (DEPTH, D_MODEL)),
        'norm_post': 1.0 + 0.05 * nrm(ks[9], (DEPTH, D_MODEL)),
        'w_in': nrm(ks[10], (DEPTH, D_MODEL, IN_WIDTH)) * D_MODEL ** -0.5,
        'q_norm': 1.0 + 0.05 * nrm(ks[11], (DEPTH, HEAD_DIM)),
        'k_norm': 1.0 + 0.05 * nrm(ks[12], (DEPTH, HEAD_DIM)),
        'w_out': nrm(ks[13], (DEPTH, ATTN_WIDTH, D_MODEL)) * ATTN_WIDTH ** -0.5,
        'sink_logit': 0.5 * nrm(ks[14], (N_B_LAYERS, N_HEADS)),
        'na_rel_bias': 0.1 * nrm(ks[15], (N_C_LAYERS, N_HEADS, 2 * NA_MAX_ROWS - 1, 2 * NA_COLS - 1)),
    }


def reference(x_prompt, x_sample, cache_k, cache_v, c, c_ctx, w_mod, b_mod, norm_pre, norm_post,
              w_in, q_norm, k_norm, w_out, sink_logit, na_rel_bias):
    n_lat = x_sample.shape[1]
    cos, sin = rope_tables(n_lat)
    h_ctx, h_lat = x_prompt, x_sample
    new_k, new_v = [], []
    for l in range(DEPTH):
        kind = l % N_MIXERS
        sink = sink_logit[l // N_MIXERS].reshape(N_KV_HEADS, GROUP) if kind == 1 else None

        shift, scl, gate = modulation(c_ctx, w_mod[l], b_mod[l])
        u = rms_norm(h_ctx, norm_pre[l]) * (1 + scl) + shift
        q, k, v, z = project(u, w_in[l], q_norm[l], k_norm[l])
        new_k.append(k)
        new_v.append(v)
        o = dense_attention(q, k, v, sink)
        h_ctx = h_ctx + gate * rms_norm(branch_out(o, z, w_out[l]), norm_post[l])

        shift, scl, gate = modulation(c, w_mod[l], b_mod[l])
        u = rms_norm(h_lat, norm_pre[l]) * (1 + scl[:, None, :]) + shift[:, None, :]
        q, k, v, z = project(u, w_in[l], q_norm[l], k_norm[l])
        k_ctx, v_ctx = cache_k[:, l], cache_v[:, l]
        if kind == 0:
            q, k = apply_rope(q, cos, sin), apply_rope(k, cos, sin)
            o = dense_attention(q, jnp.concatenate([k, k_ctx], axis=1),
                                jnp.concatenate([v, v_ctx], axis=1), None)
        elif kind == 1:
            q, k = apply_rope(q, cos, sin), apply_rope(k, cos, sin)
            o = window_attention(q, k, v, k_ctx, v_ctx, sink)
        else:
            o = neighborhood_attention(q, k, v, k_ctx, v_ctx, na_rel_bias[l // N_MIXERS])
        h_lat = h_lat + gate[:, None, :] * rms_norm(branch_out(o, z, w_out[l]), norm_post[l])

    new_cache_k = jnp.stack(new_k, axis=1)
    new_cache_v = jnp.stack(new_v, axis=1)
    return (h_ctx, h_lat, new_cache_k, new_cache_v)
```

```cpp
#include <hip/hip_runtime.h>
#include <cstdio>
#include <cstdint>
__device__ __forceinline__ int opq_tid() { int t = threadIdx.x; asm volatile("" : "+v"(t)); return t; }
__device__ __forceinline__ int opq_s(int v) { asm volatile("" : "+s"(v)); return v; }
namespace pg8 {
#define PG8_LAS __attribute__((address_space(3)))
typedef unsigned short bf16_t;
typedef short bf16x8 __attribute__((ext_vector_type(8)));
typedef float f32x4 __attribute__((ext_vector_type(4)));
typedef unsigned u32x4 __attribute__((ext_vector_type(4)));
constexpr int BM = 256, BK = 64, HALF = 128, HTB = HALF * BK * 2  , STAGE_BYTES = 8 * HTB, NXCD = 8, WGM = 8;

__host__ __device__ __forceinline__ int lds_byte(int r, int c) { const int st = (r >> 4) * 2 + (c >> 5), rr = r & 15, cc = c & 31, ob = rr * 64 + cc * 2; return st * 1024 + (ob ^ (((ob >> 9) & 1) << 5)); }
__host__ __device__ __forceinline__ void stage_rc(int b, int& R, int& C) { const int st = b / 1024, sb = b % 1024, swz = sb ^ (((sb >> 9) & 1) << 5); R = (st >> 1) * 16 + swz / 64; C = (st & 1) * 32 + (swz % 64) / 2; }
__host__ __device__ __forceinline__ int perm32(int rho) { const int n = rho >> 4, i = rho & 15; return 8 * (i >> 2) + 4 * n + (i & 3); }

struct Unit { int pm, pn; };
struct Gemm { const bf16_t* A; const bf16_t* Bt; int M, N, K; };

struct StaticOrder {
    int nM, nN, nwg, G, c;
    __host__ __device__ void init(int M, int N, int G_, int c_) { nM = M / BM; nN = N / BM; nwg = nM * nN; G = G_; c = c_; }
    __host__ __device__ bool next(int i, Unit& u) const {
        const long L = (long)i * G + c; if (L >= nwg) return false;
        int wgid = (int)L; { const int q = nwg / NXCD, r = nwg % NXCD, xcd = wgid % NXCD, off = wgid / NXCD; wgid = (xcd < r ? xcd * (q + 1) : r * (q + 1) + (xcd - r) * q) + off; }
        const int nig = WGM * nN, gid = wgid / nig, fm = gid * WGM, gsz = (nM - fm) < WGM ? (nM - fm) : WGM;
        u.pm = fm + ((wgid % nig) % gsz); u.pn = (wgid % nig) / gsz; return true;
    }
    __device__ __forceinline__ void a_ready(const Unit&) const {}
    __device__ __forceinline__ void done(const Unit&) const {}
};

__device__ __forceinline__ unsigned cvt_pk_bf16(float lo, float hi) { unsigned r; asm volatile("v_cvt_pk_bf16_f32 %0, %1, %2" : "=v"(r) : "v"(lo), "v"(hi)); return r; }
typedef float f32x2 __attribute__((ext_vector_type(2)));
__device__ __forceinline__ f32x2 gelu_pk(f32x2 v) {
    const f32x2 av = __builtin_elementwise_abs(v), d = av * 0.2316418882f + 1.0f;
    f32x2 t; t.x = __builtin_amdgcn_rcpf(d.x); t.y = __builtin_amdgcn_rcpf(d.y);
    f32x2 q = t * 0.5307027145f + (-0.7265760135f); q = q * t + 0.7107068705f; q = q * t + (-0.142248368f); q = q * t + 0.127414796f; q = q * t;
    const f32x2 s = (v * v) * (-0.72134752044f);
    f32x2 e; e.x = __builtin_amdgcn_exp2f(s.x); e.y = __builtin_amdgcn_exp2f(s.y);
    const f32x2 m = v * (q * e), r = v - m;
    f32x2 o; o.x = v.x < 0.f ? m.x : r.x; o.y = v.y < 0.f ? m.y : r.y; return o;
}

template <int ACT  > struct EpiBf16 {
    static constexpr bool PERM = true, AFTER_DRAIN = false; static_assert(ACT == 0 || ACT == 1, "EpiBf16: ACT is 0 (none) or 1 (gelu_pk)");
    bf16_t* O; int ldc; const float* bias; int split_cols; size_t split_stride; float scale0;
    __device__ __forceinline__ void operator()(const f32x4 (&acc)[2][2][4][2], const Unit& u, int wr, int wc, int fr, int fq) const {
        const int row0 = u.pm * BM + wr * 64 + fr; int colt = u.pn * BM; bf16_t* base = O;
        float sc = 1.f; if (split_cols) { const int t = colt / split_cols; base += (size_t)t * split_stride; colt -= t * split_cols; if (t == 0) sc = scale0; }
        const int col0 = colt + wc * 32 + 8 * fq, bcol0 = u.pn * BM + wc * 32 + 8 * fq;
        f32x4 bv[2][2];
#pragma unroll
        for (int bj = 0; bj < 2; ++bj)
#pragma unroll
            for (int n = 0; n < 2; ++n) bv[bj][n] = bias ? *(const f32x4*)(bias + bcol0 + bj * HALF + 4 * n) : (f32x4){0.f, 0.f, 0.f, 0.f};
#pragma unroll
        for (int ai = 0; ai < 2; ++ai)
#pragma unroll
            for (int m = 0; m < 4; ++m) { bf16_t* rowp = base + (size_t)(row0 + ai * HALF + m * 16) * ldc + col0;
#pragma unroll
                for (int bj = 0; bj < 2; ++bj) { f32x4 v0 = acc[ai][bj][m][0] + bv[bj][0], v1 = acc[ai][bj][m][1] + bv[bj][1];
                    if (ACT == 1) { f32x2 a = gelu_pk((f32x2){v0[0], v0[1]}), b = gelu_pk((f32x2){v0[2], v0[3]}), c = gelu_pk((f32x2){v1[0], v1[1]}), d = gelu_pk((f32x2){v1[2], v1[3]});
                        v0 = (f32x4){a.x, a.y, b.x, b.y}; v1 = (f32x4){c.x, c.y, d.x, d.y}; }
                    v0 = v0 * sc; v1 = v1 * sc; u32x4 w; w.x = cvt_pk_bf16(v0[0], v0[1]); w.y = cvt_pk_bf16(v0[2], v0[3]); w.z = cvt_pk_bf16(v1[0], v1[1]); w.w = cvt_pk_bf16(v1[2], v1[3]);
                    *(u32x4*)(rowp + bj * HALF) = w; } }
    }
};
__device__ __forceinline__ float silu_f(float x) { return x * __builtin_amdgcn_rcpf(1.0f + __builtin_amdgcn_exp2f(-1.4426950408889634f * x)); }
__device__ __forceinline__ u32x4 pack8(const f32x4 a, const f32x4 b) { u32x4 w; w.x = cvt_pk_bf16(a[0], a[1]); w.y = cvt_pk_bf16(a[2], a[3]); w.z = cvt_pk_bf16(b[0], b[1]); w.w = cvt_pk_bf16(b[2], b[3]); return w; }
constexpr int MCTX = 4096, LROWS = 4352  ;
struct EpiIn {
    static constexpr bool PERM = true, AFTER_DRAIN = false;
    bf16_t *Q, *Z, *KL, *VL, *KC, *VC; float *outK, *outV;
    const float *qg, *kg, *rc, *rs; int rope, layer; float qscale;
    __device__ __forceinline__ void operator()(const f32x4 (&acc)[2][2][4][2], const Unit& u, int wr, int wc, int fr, int fq) const {
        const int pn = u.pn; const bool ctx = u.pm < (MCTX / BM);
        if (pn >= 6) {
#pragma unroll
            for (int ai = 0; ai < 2; ++ai)
#pragma unroll
                for (int m = 0; m < 4; ++m) { const int row = u.pm * BM + ai * HALF + wr * 64 + m * 16 + fr;
                    bf16_t* dst = Z + (size_t)row * 1024 + (pn - 6) * 256 + 64 * wc + 8 * fq;
#pragma unroll
                    for (int bj = 0; bj < 2; ++bj) { f32x4 a = acc[ai][bj][m][0], b = acc[ai][bj][m][1];
#pragma unroll
                        for (int e = 0; e < 4; ++e) { a[e] = silu_f(a[e]); b[e] = silu_f(b[e]); }
                        *(u32x4*)(dst + 32 * bj) = pack8(a, b); } }
        } else if (pn == 5) {
#pragma unroll
            for (int ai = 0; ai < 2; ++ai)
#pragma unroll
                for (int m = 0; m < 4; ++m) { const int row = u.pm * BM + ai * HALF + wr * 64 + m * 16 + fr; const int col = 64 * wc + 8 * fq;
                    if (ctx) { bf16_t* dst = VC + (size_t)row * 256 + col; float* od = outV + ((size_t)((row >> 8) * 4 + layer) * 256 + (row & 255)) * 256 + col;
#pragma unroll
                        for (int bj = 0; bj < 2; ++bj) { *(u32x4*)(dst + 32 * bj) = pack8(acc[ai][bj][m][0], acc[ai][bj][m][1]); *(f32x4*)(od + 32 * bj) = acc[ai][bj][m][0]; *(f32x4*)(od + 32 * bj + 4) = acc[ai][bj][m][1]; }
                    } else { const int ml = row - MCTX; bf16_t* dst = VL + ((size_t)(ml >> 12) * LROWS + 256 + (ml & 4095)) * 256 + col;
#pragma unroll
                        for (int bj = 0; bj < 2; ++bj) *(u32x4*)(dst + 32 * bj) = pack8(acc[ai][bj][m][0], acc[ai][bj][m][1]); } }
        } else {
            const bool isq = pn < 4; const float* gp = (isq ? qg : kg) + 8 * fq;
            const f32x4 g00 = *(const f32x4*)(gp), g01 = *(const f32x4*)(gp + 4), g10 = *(const f32x4*)(gp + 32), g11 = *(const f32x4*)(gp + 36);
            const float sc = isq ? qscale : 1.0f;
#pragma unroll
            for (int ai = 0; ai < 2; ++ai)
#pragma unroll
                for (int m = 0; m < 4; ++m) { const int row = u.pm * BM + ai * HALF + wr * 64 + m * 16 + fr;
                    f32x4 x00 = acc[ai][0][m][0], x01 = acc[ai][0][m][1], x10 = acc[ai][1][m][0], x11 = acc[ai][1][m][1];
                    float ss = 0.f;
#pragma unroll
                    for (int e = 0; e < 4; ++e) ss += x00[e] * x00[e] + x01[e] * x01[e] + x10[e] * x10[e] + x11[e] * x11[e];
                    ss += __shfl_xor(ss, 16); ss += __shfl_xor(ss, 32);
                    const float r = __builtin_amdgcn_rsqf(ss * (1.0f / 64.0f) + 1e-6f);
                    x00 = x00 * r * g00; x01 = x01 * r * g01; x10 = x10 * r * g10; x11 = x11 * r * g11;
                    if (!ctx && rope) { const int t = (row - MCTX) & 4095; const int pos = (fq < 2) ? (t >> 6) : (t & 63); const float* cp = rc + pos * 16 + 8 * (fq & 1); const float* sp = rs + pos * 16 + 8 * (fq & 1);
                        const f32x4 c0 = *(const f32x4*)cp, c1 = *(const f32x4*)(cp + 4), s0 = *(const f32x4*)sp, s1 = *(const f32x4*)(sp + 4);
                        const f32x4 a0 = x00 * c0 - x10 * s0, b0 = x10 * c0 + x00 * s0, a1 = x01 * c1 - x11 * s1, b1 = x11 * c1 + x01 * s1;
                        x00 = a0; x10 = b0; x01 = a1; x11 = b1; }
                    if (isq) { bf16_t* dst = Q + (size_t)row * 1024 + (4 * pn + wc) * 64 + 8 * fq;
                        *(u32x4*)(dst) = pack8(x00 * sc, x01 * sc); *(u32x4*)(dst + 32) = pack8(x10 * sc, x11 * sc);
                    } else if (ctx) { const int col = 64 * wc + 8 * fq; bf16_t* dst = KC + (size_t)row * 256 + col; float* od = outK + ((size_t)((row >> 8) * 4 + layer) * 256 + (row & 255)) * 256 + col;
                        *(u32x4*)(dst) = pack8(x00, x01); *(u32x4*)(dst + 32) = pack8(x10, x11);
                        *(f32x4*)(od) = x00; *(f32x4*)(od + 4) = x01; *(f32x4*)(od + 32) = x10; *(f32x4*)(od + 36) = x11;
                    } else { const int ml = row - MCTX; bf16_t* dst = KL + ((size_t)(ml >> 12) * LROWS + 256 + (ml & 4095)) * 256 + 64 * wc + 8 * fq;
                        *(u32x4*)(dst) = pack8(x00, x01); *(u32x4*)(dst + 32) = pack8(x10, x11); } }
        }
    }
};
struct EpiOut {
    static constexpr bool PERM = true, AFTER_DRAIN = false;
    bf16_t* Y; float* SSQ;
    __device__ __forceinline__ void operator()(const f32x4 (&acc)[2][2][4][2], const Unit& u, int wr, int wc, int fr, int fq) const {
#pragma unroll
        for (int ai = 0; ai < 2; ++ai)
#pragma unroll
            for (int m = 0; m < 4; ++m) { const int row = u.pm * BM + ai * HALF + wr * 64 + m * 16 + fr; bf16_t* dst = Y + (size_t)row * 1024 + u.pn * BM + 32 * wc + 8 * fq; float ss = 0.f;
#pragma unroll
                for (int bj = 0; bj < 2; ++bj) { const f32x4 a = acc[ai][bj][m][0], b = acc[ai][bj][m][1];
#pragma unroll
                    for (int e = 0; e < 4; ++e) ss += a[e] * a[e] + b[e] * b[e];
                    *(u32x4*)(dst + bj * HALF) = pack8(a, b); }
                ss += __shfl_xor(ss, 16); ss += __shfl_xor(ss, 32);
                if (fq == 0) SSQ[(size_t)row * 16 + u.pn * 4 + wc] = ss; }
    }
};

template <class Epi, class Sched, bool ALIGN_EPI = false, bool SP2 = false>
__device__ __forceinline__ void gemm_phase(PG8_LAS unsigned char* lds, const Gemm g, const Sched& S, const Epi& E) {
    const int tid = opq_tid(), wid = __builtin_amdgcn_readfirstlane(tid >> 6), lane = tid & 63, wr = wid >> 2, wc = wid & 3, fr = lane & 15, fq = lane >> 4;
    const int K = g.K, nt = K / BK;
    unsigned voffA[2], voffB[2];
#pragma unroll
    for (int i = 0; i < 2; ++i) { int R, C; stage_rc(tid * 16 + i * 8192, R, C); const int Rb = Epi::PERM ? ((R & ~31) + perm32(R & 31)) : R;
        voffA[i] = (unsigned)(R * K + C) * 2u; voffB[i] = (unsigned)(Rb * K + C) * 2u; }
    const size_t kstep = (size_t)(BK * 2);
    const size_t hstep = (size_t)HALF * K * 2;
    const size_t tstep = 2 * hstep;
    const unsigned ldsw = (unsigned)wid * 1024u;
    const int aoff = lds_byte(wr * 64 + fr, fq * 8), boff = lds_byte(wc * 32 + fr, fq * 8);
#define PG8_SA(b, h) (((b) * 2 + (h)) * HTB)
#define PG8_SB(b, h) ((4 + (b) * 2 + (h)) * HTB)
#define PG8_STAGE(bufoff, gbase, voff) do { _Pragma("unroll") for (int _i = 0; _i < 2; ++_i) \
        __builtin_amdgcn_global_load_lds((const unsigned*)((const char*)(gbase) + (voff)[_i]), (PG8_LAS unsigned*)(lds + (bufoff) + ldsw + _i * 8192), 16, 0, 0); } while (0)
#define PG8_LDA(dst, b, h) do { _Pragma("unroll") for (int m = 0; m < 4; ++m) _Pragma("unroll") for (int k = 0; k < 2; ++k) dst[m][k] = *(const PG8_LAS bf16x8*)(lds + PG8_SA(b, h) + aoff + m * 2048 + k * 1024); } while (0)
#define PG8_LDB(dst, b, h) do { _Pragma("unroll") for (int n = 0; n < 2; ++n) _Pragma("unroll") for (int k = 0; k < 2; ++k) dst[n][k] = *(const PG8_LAS bf16x8*)(lds + PG8_SB(b, h) + boff + n * 2048 + k * 1024); } while (0)
#define PG8_MMA(ai, bj, At, Bt) do { __builtin_amdgcn_s_setprio(1); _Pragma("unroll") for (int m = 0; m < 4; ++m) _Pragma("unroll") for (int n = 0; n < 2; ++n) _Pragma("unroll") for (int k = 0; k < 2; ++k) \
        acc[ai][bj][m][n] = __builtin_amdgcn_mfma_f32_16x16x32_bf16(Bt[n][k], At[m][k], acc[ai][bj][m][n], 0, 0, 0); __builtin_amdgcn_s_setprio(0); } while (0)
#define PG8_WAIT_V(n) asm volatile("s_waitcnt vmcnt(" #n ")" ::: "memory")
#define PG8_WAIT_L(n) asm volatile("s_waitcnt lgkmcnt(" #n ")" ::: "memory")
#define PG8_BAR __builtin_amdgcn_s_barrier()
#define PG8_SCHED __builtin_amdgcn_sched_barrier(0)
    Unit cur, nxt; int ui = 0;
    if (!S.next(0, cur)) return;
    f32x4 acc[2][2][4][2];
#pragma unroll
    for (int a = 0; a < 2; ++a)
#pragma unroll
        for (int b = 0; b < 2; ++b)
#pragma unroll
            for (int m = 0; m < 4; ++m)
#pragma unroll
                for (int n = 0; n < 2; ++n) acc[a][b][m][n] = (f32x4){0.f, 0.f, 0.f, 0.f};
    bf16x8 At[4][2], B0[2][2], B1[2][2];
    const char* cA = (const char*)g.A + (size_t)cur.pm * tstep; const char* cB = (const char*)g.Bt + (size_t)cur.pn * tstep;
    S.a_ready(cur);
    if constexpr (SP2) {
        PG8_STAGE(PG8_SB(0, 0), cB, voffB); PG8_STAGE(PG8_SB(0, 1), cB + hstep, voffB); PG8_STAGE(PG8_SA(0, 0), cA, voffA); PG8_STAGE(PG8_SA(0, 1), cA + hstep, voffA);
        if (wr == 1) PG8_BAR;
        PG8_WAIT_V(2); PG8_BAR;
        PG8_STAGE(PG8_SB(1, 0), cB + kstep, voffB); PG8_STAGE(PG8_SA(1, 0), cA + kstep, voffA); PG8_STAGE(PG8_SB(1, 1), cB + hstep + kstep, voffB);
        PG8_WAIT_V(6); PG8_BAR;
    } else {
        PG8_STAGE(PG8_SB(0, 0), cB, voffB); PG8_STAGE(PG8_SA(0, 0), cA, voffA); PG8_STAGE(PG8_SB(0, 1), cB + hstep, voffB); PG8_STAGE(PG8_SA(0, 1), cA + hstep, voffA);
        if (wr == 1) PG8_BAR;
        PG8_WAIT_V(4); PG8_BAR;
        PG8_STAGE(PG8_SB(1, 0), cB + kstep, voffB); PG8_STAGE(PG8_SA(1, 0), cA + kstep, voffA); PG8_STAGE(PG8_SB(1, 1), cB + hstep + kstep, voffB);
        PG8_WAIT_V(6); PG8_BAR;
    }
    for (;;) {
        const bool has_next = S.next(ui + 1, nxt);
        const char* nA = has_next ? (const char*)g.A + (size_t)nxt.pm * tstep : cA; const char* nB = has_next ? (const char*)g.Bt + (size_t)nxt.pn * tstep : cB;
        for (int t = 0; t < nt; t += 2) {
            const bool last = (t == nt - 2);
            const char* a1 = cA + (size_t)(t + 1) * kstep;
            const char* a2 = last ? nA : cA + (size_t)(t + 2) * kstep; const char* b2 = last ? nB : cB + (size_t)(t + 2) * kstep;
            const char* a3 = a2 + kstep; const char* b3 = b2 + kstep;
            if (last && has_next) S.a_ready(nxt);
            if constexpr (SP2) {
            PG8_LDB(B0, 0, 0); PG8_LDB(B1, 0, 1); PG8_SCHED; PG8_LDA(At, 0, 0); PG8_STAGE(PG8_SA(1, 1), a1 + hstep, voffA);
            PG8_WAIT_V(8); PG8_WAIT_L(0); PG8_BAR; PG8_MMA(0, 0, At, B0); PG8_MMA(0, 1, At, B1); PG8_BAR; PG8_SCHED;
            PG8_LDA(At, 0, 1); PG8_STAGE(PG8_SB(0, 0), b2, voffB); PG8_STAGE(PG8_SB(0, 1), b2 + hstep, voffB); PG8_STAGE(PG8_SA(0, 0), a2, voffA);
            PG8_WAIT_V(8); PG8_WAIT_L(0); PG8_BAR; PG8_MMA(1, 0, At, B0); PG8_MMA(1, 1, At, B1); PG8_BAR; PG8_SCHED;
            PG8_LDB(B0, 1, 0); PG8_LDB(B1, 1, 1); PG8_SCHED; PG8_LDA(At, 1, 0); PG8_STAGE(PG8_SA(0, 1), a2 + hstep, voffA);
            PG8_WAIT_V(8); PG8_WAIT_L(0); PG8_BAR; PG8_MMA(0, 0, At, B0); PG8_MMA(0, 1, At, B1); PG8_BAR; PG8_SCHED;
            PG8_LDA(At, 1, 1); PG8_STAGE(PG8_SB(1, 0), b3, voffB); PG8_STAGE(PG8_SB(1, 1), b3 + hstep, voffB); PG8_STAGE(PG8_SA(1, 0), a3, voffA);
            PG8_WAIT_V(8); PG8_WAIT_L(0); PG8_BAR; PG8_MMA(1, 0, At, B0); PG8_MMA(1, 1, At, B1); PG8_BAR; PG8_SCHED;
            } else {
            PG8_LDB(B0, 0, 0); PG8_SCHED; PG8_LDA(At, 0, 0); PG8_STAGE(PG8_SA(1, 1), a1 + hstep, voffA);
            PG8_WAIT_L(8); PG8_BAR; PG8_WAIT_L(0); PG8_MMA(0, 0, At, B0); PG8_BAR; PG8_SCHED;
            PG8_LDB(B1, 0, 1); PG8_STAGE(PG8_SB(0, 0), b2, voffB);
            PG8_BAR; PG8_WAIT_L(0); PG8_MMA(0, 1, At, B1); PG8_BAR;
            PG8_LDA(At, 0, 1); PG8_STAGE(PG8_SA(0, 0), a2, voffA);
            PG8_BAR; PG8_WAIT_L(0); PG8_MMA(1, 0, At, B0); PG8_BAR; PG8_SCHED;
            PG8_STAGE(PG8_SB(0, 1), b2 + hstep, voffB);
            PG8_WAIT_V(6); PG8_BAR; PG8_MMA(1, 1, At, B1); PG8_BAR;
            PG8_LDB(B0, 1, 0); PG8_SCHED; PG8_LDA(At, 1, 0); PG8_STAGE(PG8_SA(0, 1), a2 + hstep, voffA);
            PG8_WAIT_L(8); PG8_BAR; PG8_WAIT_L(0); PG8_MMA(0, 0, At, B0); PG8_BAR; PG8_SCHED;
            PG8_LDB(B1, 1, 1); PG8_STAGE(PG8_SB(1, 0), b3, voffB);
            PG8_BAR; PG8_WAIT_L(0); PG8_MMA(0, 1, At, B1); PG8_BAR;
            PG8_LDA(At, 1, 1); PG8_STAGE(PG8_SA(1, 0), a3, voffA);
            PG8_BAR; PG8_WAIT_L(0); PG8_MMA(1, 0, At, B0); PG8_BAR; PG8_SCHED;
            PG8_STAGE(PG8_SB(1, 1), b3 + hstep, voffB);
            PG8_WAIT_V(6); PG8_BAR; PG8_MMA(1, 1, At, B1); PG8_BAR;
            }
        }
        if constexpr (ALIGN_EPI) { if (wr == 0) PG8_BAR; }
        if constexpr (!Epi::AFTER_DRAIN) { E(acc, cur, wr, wc, fr, fq); S.done(cur); }
        if (!has_next) break;
#pragma unroll
        for (int a = 0; a < 2; ++a)
#pragma unroll
            for (int b = 0; b < 2; ++b)
#pragma unroll
                for (int m = 0; m < 4; ++m)
#pragma unroll
                    for (int n = 0; n < 2; ++n) acc[a][b][m][n] = (f32x4){0.f, 0.f, 0.f, 0.f};
        cur = nxt; cA = nA; cB = nB; ++ui;
        if constexpr (ALIGN_EPI) { if (wr == 1) PG8_BAR; }
    }
    PG8_WAIT_V(0);
    if constexpr (!ALIGN_EPI) { if (wr == 0) PG8_BAR; }
    PG8_BAR;
    if constexpr (Epi::AFTER_DRAIN) { E.fused(acc, cur, wr, wc, fr, fq, lds, wid, lane); S.done(cur); }
#undef PG8_SA
#undef PG8_SB
#undef PG8_STAGE
#undef PG8_LDA
#undef PG8_LDB
#undef PG8_MMA
#undef PG8_WAIT_V
#undef PG8_WAIT_L
#undef PG8_BAR
#undef PG8_SCHED
}
}

#ifndef PG8_SP2
#define PG8_SP2 true
#endif
#ifndef PG8_ALIGN
#define PG8_ALIGN true
#endif
#include <hip/hip_bf16.h>
#include <cmath>
namespace attn_body {
using bf16=__hip_bfloat16;
using bf16x8=__attribute__((ext_vector_type(8)))short;
using s16x4=__attribute__((ext_vector_type(4)))short;
using f32x16=__attribute__((ext_vector_type(16)))float;
using u32x4=__attribute__((ext_vector_type(4)))unsigned;
constexpr int NHEAD=16,D=64,DM=NHEAD*D,KP=256;
constexpr int NW=8,QBLK=32,QB=QBLK*NW,KVBLK=64;
constexpr int ATTN_PITCH=DM, ATTN_UNIT_ROWS=QB;
__device__ __forceinline__ int crow(int r,int hi){return (r&3)+8*(r>>2)+4*hi;}
#define SBAR() __builtin_amdgcn_sched_barrier(0)
constexpr int NSLOT=3, SLOTB=8192;
constexpr int LDS_K=0, LDS_V=NSLOT*SLOTB, LDS_WS=2*NSLOT*SLOTB, LDS_OST=LDS_WS+NW*64*4, LDS_BIAS=LDS_OST+NW*4096, LDS_BYTES=LDS_BIAS+2048;
constexpr float C2=0.125f*1.4426950408889634f;
__device__ __forceinline__ void glds16(const void*gsrc,unsigned lds_dst){unsigned keep;
  asm volatile("s_mov_b32 %0, m0\n\ts_mov_b32 m0, %2\n\ts_nop 0\n\tglobal_load_lds_dwordx4 %1, off\n\ts_mov_b32 m0, %0":"=&s"(keep):"v"(gsrc),"s"(lds_dst):"memory");}
__device__ __forceinline__ float max3f(float a,float b,float c){float r;asm("v_max3_f32 %0, %1, %2, %3":"=v"(r):"v"(a),"v"(b),"v"(c));return r;}
__device__ __forceinline__ float max2f(float a,float b){float r;asm("v_max_f32_e32 %0, %1, %2":"=v"(r):"v"(a),"v"(b));return r;}
__device__ __forceinline__ float fadd_s(float a,float b){float r;asm("v_add_f32_e32 %0, %1, %2":"=v"(r):"v"(a),"v"(b));return r;}
__device__ __forceinline__ float fsub_s(float a,float b){float r;asm("v_sub_f32_e32 %0, %1, %2":"=v"(r):"v"(a),"v"(b));return r;}
typedef float f32x2_t __attribute__((ext_vector_type(2))); typedef __bf16 bf16x2_t __attribute__((ext_vector_type(2)));
__device__ __forceinline__ unsigned cvtpk_s(float lo,float hi){f32x2_t v={lo,hi};bf16x2_t b=__builtin_convertvector(v,bf16x2_t);return __builtin_bit_cast(unsigned,b);}
#define WAIT_BAR(N) asm volatile("s_waitcnt vmcnt(" #N ") lgkmcnt(0)\n\ts_barrier":::"memory")

__device__ __forceinline__ void qkt(f32x16&p0,f32x16&p1,const char*Kslot,const bf16x8*qr,const f32x16&negm,int r32,int hi){
  const char*kb=Kslot+hi*1024+r32*16;
  #pragma unroll
  for(int d0=0;d0<4;++d0){
    const bf16x8 b0=*reinterpret_cast<const bf16x8*>(kb+d0*2048);
    const bf16x8 b1=*reinterpret_cast<const bf16x8*>(kb+d0*2048+512);
    if(d0==0){p0=__builtin_amdgcn_mfma_f32_32x32x16_bf16(b0,qr[0],negm,0,0,0);p1=__builtin_amdgcn_mfma_f32_32x32x16_bf16(b1,qr[0],negm,0,0,0);}
    else{p0=__builtin_amdgcn_mfma_f32_32x32x16_bf16(b0,qr[d0],p0,0,0,0);p1=__builtin_amdgcn_mfma_f32_32x32x16_bf16(b1,qr[d0],p1,0,0,0);}}
}
typedef __attribute__((address_space(3))) const char* lds_cptr;
typedef short v4i16_t __attribute__((ext_vector_type(4)));
__device__ __forceinline__ void kload8(bf16x8*kf,lds_cptr kp){
  kf[0]=*(const __attribute__((address_space(3))) bf16x8*)(kp);      kf[1]=*(const __attribute__((address_space(3))) bf16x8*)(kp+512);
  kf[2]=*(const __attribute__((address_space(3))) bf16x8*)(kp+2048); kf[3]=*(const __attribute__((address_space(3))) bf16x8*)(kp+2560);
  kf[4]=*(const __attribute__((address_space(3))) bf16x8*)(kp+4096); kf[5]=*(const __attribute__((address_space(3))) bf16x8*)(kp+4608);
  kf[6]=*(const __attribute__((address_space(3))) bf16x8*)(kp+6144); kf[7]=*(const __attribute__((address_space(3))) bf16x8*)(kp+6656);
}
__device__ __forceinline__ void kload2(bf16x8*kf,lds_cptr kp,int j){ kf[2*j]=*(const __attribute__((address_space(3))) bf16x8*)(kp+j*2048); kf[2*j+1]=*(const __attribute__((address_space(3))) bf16x8*)(kp+j*2048+512); }
__device__ __forceinline__ s16x4 vtr(lds_cptr p){ return __builtin_bit_cast(s16x4,__builtin_amdgcn_ds_read_tr16_b64_v4i16((__attribute__((address_space(3))) v4i16_t*)p)); }
__device__ __forceinline__ float rowmax(const f32x16&p0,const f32x16&p1){
  float a=max3f(p0[0],p0[1],p1[0]),b=max3f(p0[2],p0[3],p1[1]);a=max3f(a,p1[2],p1[3]);
  #pragma unroll
  for(int r=4;r<16;r+=4){a=max3f(a,p0[r],p0[r+1]);b=max3f(b,p0[r+2],p0[r+3]);a=max3f(a,p1[r],p1[r+1]);b=max3f(b,p1[r+2],p1[r+3]);}
  const float m=max2f(a,b);
  auto rr=__builtin_amdgcn_permlane32_swap(__float_as_uint(m),__float_as_uint(m),false,false);
  return max2f(__uint_as_float(rr[0]),__uint_as_float(rr[1]));
}
__device__ __forceinline__ void pv(f32x16*o,int vb,bf16x8 pa0,bf16x8 pa1,bf16x8 pa2,bf16x8 pa3){
  #pragma unroll
  for(int d0=0;d0<2;++d0){s16x4 lo[4],hi[4];
    #pragma unroll
    for(int ks=0;ks<4;++ks){
      asm volatile("ds_read_b64_tr_b16 %0,%1 offset:%c2":"=&v"(lo[ks]):"v"(vb),"i"(d0*4096+ks*1024):"memory");
      asm volatile("ds_read_b64_tr_b16 %0,%1 offset:%c2":"=&v"(hi[ks]):"v"(vb),"i"(d0*4096+ks*1024+512):"memory");}
    asm volatile("s_waitcnt lgkmcnt(0)":::"memory");SBAR();
    #define PK(k) (bf16x8){lo[k][0],lo[k][1],lo[k][2],lo[k][3],hi[k][0],hi[k][1],hi[k][2],hi[k][3]}
    o[d0]=__builtin_amdgcn_mfma_f32_32x32x16_bf16(pa0,PK(0),o[d0],0,0,0);
    o[d0]=__builtin_amdgcn_mfma_f32_32x32x16_bf16(pa1,PK(1),o[d0],0,0,0);
    o[d0]=__builtin_amdgcn_mfma_f32_32x32x16_bf16(pa2,PK(2),o[d0],0,0,0);
    o[d0]=__builtin_amdgcn_mfma_f32_32x32x16_bf16(pa3,PK(3),o[d0],0,0,0);
    #undef PK
  }
}


template<int MODE> __device__ __forceinline__ const f32x16& pick(const f32x16&c,const f32x16&negm){ if constexpr(MODE!=0) return c; else return negm; }
template<int MODE> __device__ __forceinline__ void cinit(f32x16&c0,f32x16&c1,const f32x16&negm,int t,int hi,int qpos,int ltok0,const __attribute__((address_space(3))) float*btab){
  c0=negm; c1=negm;
  if(t>=4){ const float NEG=-INFINITY;
    if constexpr(MODE==1){ const int d0=ltok0+64*(t-4)+4*hi-qpos+128;
      #pragma unroll
      for(int r=0;r<16;++r){ const int d=d0+(r&3)+8*(r>>2); if((unsigned)d>256u)c0[r]=NEG; if((unsigned)(d+32)>256u)c1[r]=NEG; } }
    else { const int rq=qpos>>6,cq=qpos&63; const int rs=min(max(rq-4,0),56),cs=min(max(cq-8,0),48); const int kr=(ltok0>>6)+(t-4);
      const bool rowok=(unsigned)(kr-rs)<8u; const int ib=(kr-rq+7)*31+15-cq;
      #pragma unroll
      for(int r=0;r<16;++r){ const int kc=4*hi+(r&3)+8*(r>>2);
        const bool ok0=rowok&&((unsigned)(kc-cs)<16u), ok1=rowok&&((unsigned)(kc+32-cs)<16u);
        const float b0=btab[ok0?ib+kc:0], b1=btab[ok1?ib+kc+32:0];
        c0[r]=ok0?(negm[r]+b0):NEG; c1[r]=ok1?(negm[r]+b1):NEG; } } }
}
#ifndef ATTN_STORE16
#define ATTN_STORE16(p,v) (*(u32x4*)(p)=(v))
#endif
template<int THRL,int MODE> __device__ __forceinline__ void attn_unit(const bf16*Qu,const bf16*__restrict__ Kh,const bf16*__restrict__ Vh,bf16*Ou,const bf16*Zu,const int NT,const int lrow,const int qtok0,const int ltok0,const float sink2,char*shm){
  const int tid=opq_tid(),lane=tid&63,r32=lane&31,hi=lane>>5; const int wid=__builtin_amdgcn_readfirstlane(tid>>6);
  const bf16*Qw=Qu+(long)(wid*QBLK)*DM;
  const unsigned lds0=(unsigned)(uintptr_t)shm;
  float*wsf=(float*)(shm+LDS_WS)+wid*64;
  const bf16*ksrc=Kh+(long)lane*KP+wid*8;
  const bf16*vsrc=Vh+(long)(16*(wid&3)+(lane>>2))*KP+(wid>>2)*32+(lane&3)*8;
  const unsigned kdst=lds0+LDS_K+wid*1024, vdst=lds0+LDS_V+wid*1024;
  #define TROW(t) (((t)<4)?64*(t):lrow+64*((t)-4))
  #define DMA_K(t,slot) glds16(ksrc+(long)TROW(t)*KP,(unsigned)__builtin_amdgcn_readfirstlane(kdst+(slot)))
  #define DMA_V(t,slot) glds16(vsrc+(long)TROW(t)*KP,(unsigned)__builtin_amdgcn_readfirstlane(vdst+(slot)))
  const int vb0=(int)(lds0+LDS_V)+((lane>>4)&1)*32+(lane&3)*8+(4*hi+((lane&15)>>2))*64;
  const char*Kbase=shm+LDS_K; bf16x8 kf[8];
  const lds_cptr shm3=(lds_cptr)shm; const lds_cptr kp0=shm3+LDS_K+hi*1024+r32*16; const lds_cptr vp0=shm3+LDS_V+((lane>>4)&1)*32+(lane&3)*8+(4*hi+((lane&15)>>2))*64;
  DMA_K(0,0);DMA_V(0,0);DMA_K(1,SLOTB);
  bf16x8 qr[4];
  #pragma unroll
  for(int d0=0;d0<4;++d0)qr[d0]=*reinterpret_cast<const bf16x8*>(&Qw[(long)r32*DM+d0*16+hi*8]);
  float mhat=0.f,l_reg=0.f;f32x16 o[2];o[0]=f32x16{};o[1]=f32x16{};f32x16 negm=f32x16{};asm volatile("":"+v"(negm));
  const int qpos=qtok0+wid*QBLK+r32; const __attribute__((address_space(3))) float* btab=(const __attribute__((address_space(3))) float*)((lds_cptr)shm+LDS_BIAS);
  bool resc=false;
  #define START(P0,P1) do{ const float rm=rowmax(P0,P1); resc=false; \
    { const float dl=rm; mhat=fadd_s(mhat,dl); \
      _Pragma("unroll") for(int r=0;r<16;++r){P0[r]=fsub_s(P0[r],dl);P1[r]=fsub_s(P1[r],dl);} \
      _Pragma("unroll") for(int r=0;r<16;++r)negm[r]=-mhat; asm volatile("":"+v"(negm)); } \
    _Pragma("unroll") for(int r=0;r<16;++r)P0[r]=__builtin_amdgcn_exp2f(P0[r]); }while(0)
  #define RESC() do{ if(resc){ asm volatile("s_waitcnt lgkmcnt(0)":::"memory"); \
      _Pragma("unroll") for(int d_=0;d_<2;++d_) _Pragma("unroll") for(int r=0;r<16;++r)o[d_][r]*=wsf[crow(r,hi)]; } }while(0)
  f32x16 pA0,pA1,pB0,pB1;
  int sl_prev=0,sl_cur=0,sl_next=SLOTB;
  #define ROT() do{sl_prev=sl_cur;sl_cur=sl_next;sl_next=(sl_next==(NSLOT-1)*SLOTB)?0:sl_next+SLOTB;}while(0)
  DMA_K(2,2*SLOTB);
  WAIT_BAR(3);
  qkt(pA0,pA1,Kbase,qr,negm,r32,hi);asm volatile("s_nop 15\n\ts_nop 7":"+v"(pA0),"+v"(pA1));
  START(pA0,pA1);
  _Pragma("unroll") for(int r=0;r<16;++r)pA1[r]=__builtin_amdgcn_exp2f(pA1[r]);
  WAIT_BAR(0);
  DMA_K(3,0);DMA_V(1,SLOTB);
  ROT();
  kload8(kf,kp0+sl_cur);
  WAIT_BAR(2);
  s16x4 vlo[8],vhi[8]; u32x4 pw0,pw1,pw2,pw3;
  #define PKW(P,B) cvtpk_s(P[B],P[B+1])
  #define PAF(k) __builtin_bit_cast(bf16x8,pw##k)
  #define VFR(i) (bf16x8){vlo[i][0],vlo[i][1],vlo[i][2],vlo[i][3],vhi[i][0],vhi[i][1],vhi[i][2],vhi[i][3]}
  #define PIN(x) asm volatile("":"+v"(x))
  #define MX3(a,b,c) __builtin_fmaxf(__builtin_fmaxf((a),(b)),(c))
  #define GAPA(MF,A0,A1,A2,A3,W0,W1,PW) do{ MF; sacc+=A0; sacc+=A1; sacc+=A2; sacc+=A3; PIN(sacc); W0; W1; PIN(PW); SBAR(); }while(0)
  #define EX(v) __builtin_amdgcn_exp2f(v)
  #define GAPB(MF,X,B) do{ MF; X[B]=EX(X[B]); X[B+1]=EX(X[B+1]); X[B+2]=EX(X[B+2]); X[B+3]=EX(X[B+3]); PIN(X); SBAR(); }while(0)
  #define VRD(i) do{ vlo[i]=vtr(vp_+(((i)>>2)*4096+((i)&3)*1024)); vhi[i]=vtr(vp_+(((i)>>2)*4096+((i)&3)*1024+512)); }while(0)
  #define KRD(G,j) do{ if(G){ kload2(kf,kp0+sl_next,j); SBAR(); } }while(0)
  #define STEP(C0,C1,P0,P1,t,GK,GV,GL) do{ if constexpr(MODE!=0){ cinit<MODE>(C0,C1,negm,(t),hi,qpos,ltok0,btab); } SBAR(); \
    const lds_cptr vp_=vp0+sl_prev; \
    VRD(0); SBAR(); float sacc=(P0[0]+P0[1]); \
    GAPA(C0=__builtin_amdgcn_mfma_f32_32x32x16_bf16(kf[0],qr[0],pick<MODE>(C0,negm),0,0,0), P0[2],P0[3],P0[4],P0[5],     pw0[0]=PKW(P0,0), pw0[1]=PKW(P0,2), pw0); \
    VRD(4); SBAR(); GAPA(C1=__builtin_amdgcn_mfma_f32_32x32x16_bf16(kf[1],qr[0],pick<MODE>(C1,negm),0,0,0), P0[6],P0[7],P0[8],P0[9],     pw0[2]=PKW(P0,4), pw0[3]=PKW(P0,6), pw0); \
    VRD(1); SBAR(); GAPA(C0=__builtin_amdgcn_mfma_f32_32x32x16_bf16(kf[2],qr[1],C0,0,0,0),   P0[10],P0[11],P0[12],P0[13], pw1[0]=PKW(P0,8), pw1[1]=PKW(P0,10), pw1); \
    VRD(5); SBAR(); GAPA(C1=__builtin_amdgcn_mfma_f32_32x32x16_bf16(kf[3],qr[1],C1,0,0,0),   P0[14],P0[15],P1[0],P1[1],   pw1[2]=PKW(P0,12),pw1[3]=PKW(P0,14), pw1); \
    VRD(2); SBAR(); GAPA(C0=__builtin_amdgcn_mfma_f32_32x32x16_bf16(kf[4],qr[2],C0,0,0,0),   P1[2],P1[3],P1[4],P1[5],     pw2[0]=PKW(P1,0), pw2[1]=PKW(P1,2), pw2); \
    VRD(6); SBAR(); GAPA(C1=__builtin_amdgcn_mfma_f32_32x32x16_bf16(kf[5],qr[2],C1,0,0,0),   P1[6],P1[7],P1[8],P1[9],     pw2[2]=PKW(P1,4), pw2[3]=PKW(P1,6), pw2); \
    VRD(3); SBAR(); GAPA(C0=__builtin_amdgcn_mfma_f32_32x32x16_bf16(kf[6],qr[3],C0,0,0,0),   P1[10],P1[11],P1[12],P1[13], pw3[0]=PKW(P1,8), pw3[1]=PKW(P1,10), pw3); \
    VRD(7); SBAR(); GAPA(C1=__builtin_amdgcn_mfma_f32_32x32x16_bf16(kf[7],qr[3],C1,0,0,0),   P1[14],P1[15],0.f,0.f,       pw3[2]=PKW(P1,12),pw3[3]=PKW(P1,14), pw3); \
    l_reg+=sacc; \
    if(GK){DMA_K((t)+3,sl_cur);} if(GV){DMA_V((t)+1,sl_next);} \
    { float a=MX3(C0[0],C0[1],C1[0]),b=MX3(C0[2],C0[3],C1[1]); a=MX3(a,C1[2],C1[3]); \
      _Pragma("unroll") for(int r=4;r<16;r+=4){a=MX3(a,C0[r],C0[r+1]);b=MX3(b,C0[r+2],C0[r+3]);a=MX3(a,C1[r],C1[r+1]);b=MX3(b,C1[r+2],C1[r+3]);} \
      float rm=__builtin_fmaxf(a,b); { auto rr=__builtin_amdgcn_permlane32_swap(__float_as_uint(rm),__float_as_uint(rm),false,false); rm=__builtin_fmaxf(__uint_as_float(rr[0]),__uint_as_float(rr[1])); } \
      resc=false; \
      if(__builtin_expect(__any(rm>(float)THRL),0)){ const float dl=__builtin_fmaxf(rm,0.f); mhat+=dl; \
        _Pragma("unroll") for(int r=0;r<16;++r){C0[r]-=dl;C1[r]-=dl;} \
        _Pragma("unroll") for(int r=0;r<16;++r)negm[r]=-mhat; asm volatile("":"+v"(negm)); \
        const float f=__builtin_amdgcn_exp2f(-dl); l_reg*=f; if(hi==0)wsf[r32]=f; resc=true; } } \
    SBAR(); \
    GAPB(o[0]=__builtin_amdgcn_mfma_f32_32x32x16_bf16(PAF(0),VFR(0),o[0],0,0,0), C0,0); \
    GAPB(o[1]=__builtin_amdgcn_mfma_f32_32x32x16_bf16(PAF(0),VFR(4),o[1],0,0,0), C0,4); \
    KRD(GL,0); GAPB(o[0]=__builtin_amdgcn_mfma_f32_32x32x16_bf16(PAF(1),VFR(1),o[0],0,0,0), C0,8); \
    KRD(GL,1); GAPB(o[1]=__builtin_amdgcn_mfma_f32_32x32x16_bf16(PAF(1),VFR(5),o[1],0,0,0), C0,12); \
    KRD(GL,2); GAPB(o[0]=__builtin_amdgcn_mfma_f32_32x32x16_bf16(PAF(2),VFR(2),o[0],0,0,0), C1,0); \
    KRD(GL,3); GAPB(o[1]=__builtin_amdgcn_mfma_f32_32x32x16_bf16(PAF(2),VFR(6),o[1],0,0,0), C1,4); \
    GAPB(o[0]=__builtin_amdgcn_mfma_f32_32x32x16_bf16(PAF(3),VFR(3),o[0],0,0,0), C1,8); \
    GAPB(o[1]=__builtin_amdgcn_mfma_f32_32x32x16_bf16(PAF(3),VFR(7),o[1],0,0,0), C1,12); \
    }while(0)
  int t=1;
  for(;t+5<NT;t+=2){
    STEP(pB0,pB1,pA0,pA1,t,true,true,true);     WAIT_BAR(2); RESC(); ROT();
    STEP(pA0,pA1,pB0,pB1,t+1,true,true,true);   WAIT_BAR(2); RESC(); ROT();
  }
  #define ENDW(tt) do{ if((tt)+3<NT){WAIT_BAR(2);} else if((tt)+2<NT){WAIT_BAR(1);} else {WAIT_BAR(0);} }while(0)
  for(;t+1<NT;t+=2){
    STEP(pB0,pB1,pA0,pA1,t,(t+3<NT),(t+1<NT),(t+1<NT));       ENDW(t);   RESC(); ROT();
    STEP(pA0,pA1,pB0,pB1,t+1,(t+4<NT),(t+2<NT),(t+2<NT));     ENDW(t+1); RESC(); ROT();
  }
  STEP(pB0,pB1,pA0,pA1,NT-1,false,false,false); RESC();
  { float sacc=pB0[0]+pB0[1]; _Pragma("unroll") for(int r=2;r<16;++r)sacc+=pB0[r]; _Pragma("unroll") for(int r=0;r<16;++r)sacc+=pB1[r]; l_reg+=sacc;
    pw0=(u32x4){PKW(pB0,0),PKW(pB0,2),PKW(pB0,4),PKW(pB0,6)};pw1=(u32x4){PKW(pB0,8),PKW(pB0,10),PKW(pB0,12),PKW(pB0,14)};pw2=(u32x4){PKW(pB1,0),PKW(pB1,2),PKW(pB1,4),PKW(pB1,6)};pw3=(u32x4){PKW(pB1,8),PKW(pB1,10),PKW(pB1,12),PKW(pB1,14)};
    SBAR(); pv(o,vb0+sl_cur,PAF(0),PAF(1),PAF(2),PAF(3)); }
  #undef PKW
  #undef PAF
  #undef VFR
  #undef PIN
  #undef MX3
  #undef GAPA
  #undef GAPB
  #undef EX
  #undef VRD
  #undef KRD
  #undef STEP
  #undef ENDW
  {auto rr=__builtin_amdgcn_permlane32_swap(__float_as_uint(l_reg),__float_as_uint(l_reg),false,false);l_reg=__uint_as_float(rr[0])+__uint_as_float(rr[1]);}
  l_reg+=__builtin_amdgcn_exp2f(sink2-mhat);
  if(hi==0)wsf[32+r32]=l_reg;asm volatile("s_waitcnt lgkmcnt(0)":::"memory");
  float rli[16];
  #pragma unroll
  for(int r=0;r<16;++r)rli[r]=__builtin_amdgcn_rcpf(wsf[32+crow(r,hi)]);
  bf16*Ow=Ou+(long)(wid*QBLK)*DM; const bf16*Zw=Zu+(long)(wid*QBLK)*DM;
  { bf16*stg=(bf16*)(shm+LDS_OST)+wid*2048;
    #pragma unroll
    for(int r=0;r<16;++r){const int orow=crow(r,hi);
      #pragma unroll
      for(int d0=0;d0<2;++d0)stg[orow*64+d0*32+r32]=__float2bfloat16(o[d0][r]*rli[r]);}
    asm volatile("s_waitcnt lgkmcnt(0)":::"memory");
    #pragma unroll
    for(int i=0;i<4;++i){const int row=i*8+(lane>>3),ch=lane&7; u32x4 v=*(const u32x4*)(stg+row*64+ch*8); const u32x4 z=*(const u32x4*)(Zw+(long)row*DM+ch*8);
      _Pragma("unroll") for(int e=0;e<4;++e){ const float lo=__uint_as_float(v[e]<<16)*__uint_as_float(z[e]<<16), hi2=__uint_as_float(v[e]&0xffff0000u)*__uint_as_float(z[e]&0xffff0000u); v[e]=cvtpk_s(lo,hi2); }
      ATTN_STORE16(Ow+(long)row*DM+ch*8,v);} }
  asm volatile("s_waitcnt lgkmcnt(0)\n\ts_barrier":::"memory");
  #undef DMA_K
  #undef DMA_V
  #undef TROW
  #undef START
  #undef RESC
  #undef ROT
}
constexpr int ATTN_LDS_BYTES=LDS_BYTES;
#undef SBAR
#undef WAIT_BAR
}
#include <hip/hip_cooperative_groups.h>
namespace cg = cooperative_groups;
#define GAS __attribute__((address_space(1)))
#define LAS __attribute__((address_space(3)))
typedef unsigned short bf16;
typedef unsigned v4u __attribute__((ext_vector_type(4)));
typedef unsigned v2u __attribute__((ext_vector_type(2)));
typedef float f32x4 __attribute__((ext_vector_type(4)));
#define LDS_WAIT() asm volatile("s_waitcnt lgkmcnt(0)" ::: "memory")
__device__ __forceinline__ unsigned f2bf(float f) { unsigned u = __builtin_bit_cast(unsigned, f); return (u + 0x7fffu + ((u >> 16) & 1u)) >> 16; }
__device__ __forceinline__ unsigned pk2(float lo, float hi) { return f2bf(lo) | (f2bf(hi) << 16); }

constexpr int NWAVES = 8;
constexpr int DM = 1024, NCTX = 4096, NLAT = 32768, MROWS = NCTX + NLAT, INW = 2560, DEPTH = 4, LROWS = 4352;
constexpr float EPS = 1e-6f, LOG2E = 1.4426950408889634f;
constexpr size_t MiB = 1u << 20;
constexpr size_t WS_ROPEC = 0, WS_ROPES = 4096, WS_BIAS2 = 8192, WS_SINK2 = 40960, WS_MOD = 65536;
constexpr size_t WS_WIN = 2 * MiB, WS_WOUT = 22 * MiB, WS_SSQ = 30 * MiB, WS_KC = 33 * MiB, WS_VC = 35 * MiB, WS_KL = 38 * MiB, WS_VL = 56 * MiB;
constexpr size_t WS_UY = 74 * MiB, WS_QO = 146 * MiB, WS_Z = 218 * MiB, WS_END = 290 * MiB;
constexpr int LDS_BYTES = 147456;
static_assert(attn_body::ATTN_LDS_BYTES <= 131072 && pg8::STAGE_BYTES <= 131072, "phase scratch");

__device__ __forceinline__ float wave_sum(float v) {
#pragma unroll
    for (int o = 1; o < 64; o <<= 1) v += __shfl_xor(v, o);
    return v;
}
template <bool PERMW>
__device__ __forceinline__ void p0_transpose_item(const float* W, int K, int N, bf16* WT, LAS float* scr, int item, int lane) {
    const int nblk = N / 32, kb = item / nblk, nb = item % nblk, k0 = 64 * kb, n0 = 32 * nb;
#pragma unroll 8
    for (int i = 0; i < 32; ++i) { const int kk = 2 * i + (lane >> 5); scr[kk * 33 + (lane & 31)] = W[(size_t)(k0 + kk) * N + n0 + (lane & 31)]; }
    LDS_WAIT(); asm volatile("" ::: "memory");
    int r0 = n0;
    if (PERMW) { const int a = n0 & 255; r0 = (n0 & ~255) + 128 * ((a >> 5) & 1) + 32 * (a >> 6); }
    const int c = lane & 7;
#pragma unroll
    for (int j = 0; j < 4; ++j) { const int n = (lane >> 3) + 8 * j; const LAS float* s = scr + (8 * c) * 33 + n;
        v4u o; o.x = pk2(s[0 * 33], s[1 * 33]); o.y = pk2(s[2 * 33], s[3 * 33]); o.z = pk2(s[4 * 33], s[5 * 33]); o.w = pk2(s[6 * 33], s[7 * 33]);
        *(v4u*)(WT + (size_t)(r0 + n) * K + k0 + 8 * c) = o; }
    LDS_WAIT(); asm volatile("" ::: "memory");
}

struct Args { const float* in[16]; float* out; unsigned char* ws; int ph_lo, ph_hi; };

__device__ __forceinline__ void phase_prologue(const Args& A, LAS unsigned char* lds) {
    const int tid = opq_tid(), lane = tid & 63, wave = __builtin_amdgcn_readfirstlane(tid >> 6), G = gridDim.x;
    unsigned char* ws = A.ws;
    const float *c = A.in[4], *c_ctx = A.in[5], *w_mod = A.in[6], *b_mod = A.in[7], *w_in = A.in[10], *w_out = A.in[13], *sink = A.in[14], *nab = A.in[15];
    {
        LAS float* scr = (LAS float*)(lds + wave * 16384);
        const int gw = blockIdx.x * NWAVES + wave, NGW = G * NWAVES;
        constexpr int I_IN = (DM / 64) * (INW / 32), I_OUT = (DM / 64) * (DM / 32), NITEMS = DEPTH * (I_IN + I_OUT);
        for (int it = gw; it < NITEMS; it += NGW) {
            if (it < DEPTH * I_IN) { const int l = it / I_IN, r = it % I_IN; p0_transpose_item<true>(w_in + (size_t)l * DM * INW, DM, INW, (bf16*)(ws + WS_WIN) + (size_t)l * INW * DM, scr, r, lane); }
            else { const int q = it - DEPTH * I_IN, l = q / I_OUT, r = q % I_OUT; p0_transpose_item<false>(w_out + (size_t)l * DM * DM, DM, DM, (bf16*)(ws + WS_WOUT) + (size_t)l * DM * DM, scr, r, lane); }
        }
    }
    __syncthreads();
    {
        LAS float* sc = (LAS float*)lds;
        LAS float* red = (LAS float*)(lds + 40960);
        for (int i = tid; i < 9 * 1024; i += NWAVES * 64) { const int j = i >> 10, k = i & 1023; const float v = (j == 0) ? c_ctx[k] : c[(j - 1) * 1024 + k]; sc[i] = v / (1.0f + __expf(-v)); }
        __syncthreads();
        float* MOD = (float*)(ws + WS_MOD);
        const int col = tid & 31, ks = tid >> 5;
        for (int un = blockIdx.x; un < DEPTH * 96; un += G) { const int l = un / 96, n0 = (un % 96) * 32;
            const float* wp = w_mod + ((size_t)l * DM + ks * 64) * 3072 + n0 + col;
            float acc[9];
#pragma unroll
            for (int j = 0; j < 9; ++j) acc[j] = 0.f;
            for (int k4 = 0; k4 < 64; k4 += 4) { const float w0 = wp[(size_t)(k4 + 0) * 3072], w1 = wp[(size_t)(k4 + 1) * 3072], w2 = wp[(size_t)(k4 + 2) * 3072], w3 = wp[(size_t)(k4 + 3) * 3072];
#pragma unroll
                for (int j = 0; j < 9; ++j) { const f32x4 s = *(const LAS f32x4*)(sc + j * 1024 + ks * 64 + k4); acc[j] += s[0] * w0 + s[1] * w1 + s[2] * w2 + s[3] * w3; } }
#pragma unroll
            for (int j = 0; j < 9; ++j) red[(ks * 9 + j) * 32 + col] = acc[j];
            __syncthreads();
            if (tid < 288) { const int j = tid >> 5; float s = b_mod[l * 3072 + n0 + col];
#pragma unroll
                for (int q = 0; q < 16; ++q) s += red[(q * 9 + j) * 32 + col];
                MOD[((size_t)l * 9 + j) * 3072 + n0 + col] = s; }
            __syncthreads();
        }
    }
    if (blockIdx.x == G - 1) {
        float* rc = (float*)(ws + WS_ROPEC); float* rs = (float*)(ws + WS_ROPES); float* b2 = (float*)(ws + WS_BIAS2); float* s2 = (float*)(ws + WS_SINK2);
        for (int i = tid; i < 1024; i += NWAVES * 64) { const int pos = i >> 4, p = i & 15; const float inv = powf(10000.0f, -(float)p / 16.0f); const float ang = (float)pos * inv; rc[i] = cosf(ang); rs[i] = sinf(ang); }
        for (int i = tid; i < 16 * 465; i += NWAVES * 64) b2[i] = nab[i] * LOG2E;
        if (tid < 16) s2[tid] = sink[tid] * LOG2E;
    }
}

__device__ __forceinline__ void phase_rows(const Args& A, int l) {
    const int tid = opq_tid(), lane = tid & 63, wave = __builtin_amdgcn_readfirstlane(tid >> 6), G = gridDim.x;
    unsigned char* ws = A.ws;
    const float* MOD = (const float*)(ws + WS_MOD);
    const float* norm_pre = A.in[8]; const float* norm_post = A.in[9];
    bf16* UY = (bf16*)(ws + WS_UY); const float* SSQ = (const float*)(ws + WS_SSQ);
    if (l < DEPTH) {
        const float* ck = A.in[2]; const float* cv = A.in[3]; bf16* KL = (bf16*)(ws + WS_KL); bf16* VL = (bf16*)(ws + WS_VL);
        for (int i = blockIdx.x * (NWAVES * 64) + tid; i < 8 * 256 * 64; i += G * NWAVES * 64) { const int b = i >> 14, r = i & 16383;
            const size_t src = ((size_t)(b * DEPTH + l) * 256 * 256) + (size_t)r * 4, dst = ((size_t)b * LROWS * 256) + (size_t)r * 4;
            const f32x4 k4 = *(const f32x4*)(ck + src), v4 = *(const f32x4*)(cv + src);
            v2u ko, vo; ko.x = pk2(k4[0], k4[1]); ko.y = pk2(k4[2], k4[3]); vo.x = pk2(v4[0], v4[1]); vo.y = pk2(v4[2], v4[3]);
            *(v2u*)(KL + dst) = ko; *(v2u*)(VL + dst) = vo; }
    }
    const int NGW = G * NWAVES, gw = blockIdx.x * NWAVES + wave, RPW = (MROWS + NGW - 1) / NGW;
    int cur = -1; f32x4 gg[4], gp[4], sh[4];
#pragma unroll
    for (int j = 0; j < 4; ++j) { gg[j] = (f32x4){0.f, 0.f, 0.f, 0.f}; gp[j] = gg[j]; sh[j] = gg[j]; }
    for (int i = 0; i < RPW; ++i) { const int row = gw * RPW + i; if (row >= MROWS) break;
        const int bidx = row < NCTX ? 0 : 1 + ((row - NCTX) >> 12);
        if (bidx != cur) { cur = bidx;
#pragma unroll
            for (int j = 0; j < 4; ++j) { const int cidx = lane * 4 + 256 * j;
                if (l > 0) { const f32x4 g = *(const f32x4*)(MOD + ((size_t)(l - 1) * 9 + bidx) * 3072 + 2048 + cidx), p = *(const f32x4*)(norm_post + (l - 1) * DM + cidx); gg[j] = g * p; }
                if (l < DEPTH) { const f32x4 s = *(const f32x4*)(MOD + ((size_t)l * 9 + bidx) * 3072 + 1024 + cidx), p = *(const f32x4*)(norm_pre + l * DM + cidx); gp[j] = p * (s + 1.0f); sh[j] = *(const f32x4*)(MOD + ((size_t)l * 9 + bidx) * 3072 + cidx); } } }
        const float* hsrc = (l <= 1) ? (row < NCTX ? A.in[0] + (size_t)row * DM : A.in[1] + (size_t)(row - NCTX) * DM) : A.out + (size_t)row * DM;
        f32x4 h[4];
#pragma unroll
        for (int j = 0; j < 4; ++j) h[j] = *(const f32x4*)(hsrc + lane * 4 + 256 * j);
        if (l > 0) { v2u y[4];
#pragma unroll
            for (int j = 0; j < 4; ++j) y[j] = *(const v2u*)(UY + (size_t)row * DM + lane * 4 + 256 * j);
            float s = lane < 16 ? SSQ[(size_t)row * 16 + lane] : 0.f; s = wave_sum(s);
            const float r = __builtin_amdgcn_rsqf(s * (1.0f / DM) + EPS);
#pragma unroll
            for (int j = 0; j < 4; ++j) { f32x4 yv; yv[0] = __uint_as_float(y[j].x << 16); yv[1] = __uint_as_float(y[j].x & 0xffff0000u); yv[2] = __uint_as_float(y[j].y << 16); yv[3] = __uint_as_float(y[j].y & 0xffff0000u);
                h[j] = h[j] + gg[j] * (yv * r); *(f32x4*)(A.out + (size_t)row * DM + lane * 4 + 256 * j) = h[j]; } }
        if (l < DEPTH) { float s2 = 0.f;
#pragma unroll
            for (int j = 0; j < 4; ++j) s2 += (h[j][0] * h[j][0] + h[j][1] * h[j][1]) + (h[j][2] * h[j][2] + h[j][3] * h[j][3]);
            s2 = wave_sum(s2); const float r2 = __builtin_amdgcn_rsqf(s2 * (1.0f / DM) + EPS);
#pragma unroll
            for (int j = 0; j < 4; ++j) { const f32x4 uv = h[j] * r2 * gp[j] + sh[j]; v2u o; o.x = pk2(uv[0], uv[1]); o.y = pk2(uv[2], uv[3]); *(v2u*)(UY + (size_t)row * DM + lane * 4 + 256 * j) = o; } }
    }
}

template <int MODE>
__device__ __forceinline__ void phase_attn(const Args& A, int l, char* lds) {
    using abf = attn_body::bf16;
    unsigned char* ws = A.ws; const int G = gridDim.x, bx = opq_s(blockIdx.x), tid = opq_tid();
    const abf* QO = (const abf*)(ws + WS_QO); const abf* Z = (const abf*)(ws + WS_Z);
    const abf* KL = (const abf*)(ws + WS_KL); const abf* VL = (const abf*)(ws + WS_VL); const abf* KC = (const abf*)(ws + WS_KC); const abf* VC = (const abf*)(ws + WS_VC);
    const float* sink2 = (const float*)(ws + WS_SINK2); const float* bias2 = (const float*)(ws + WS_BIAS2);
    for (int i = 0;; ++i) {
        int U;
        if (G == 256) { if (i >= 9) break; U = (i < 8) ? ((bx & 7) * 256 + i * 32 + (bx >> 3)) : 2048 + bx; }
        else { U = i * G + bx; if (U >= 2048 + 256) break; }
        if (U < 2048) { const int pair = U >> 6, b = pair >> 2, kvh = pair & 3, h = kvh * 4 + ((U >> 4) & 3), qb = U & 15, q0 = qb * 256;
            const size_t qoff = ((size_t)(NCTX + b * 4096 + q0)) * DM + h * 64; const size_t koff = (size_t)b * LROWS * 256 + kvh * 64;
            int NT, ltok0;
            if (MODE == 0) { NT = 68; ltok0 = 0; }
            else if (MODE == 1) { NT = 12; ltok0 = min(max(q0 - 128, 0), 4096 - 512); }
            else { NT = 16; ltok0 = 64 * min(max(4 * qb - 4, 0), 52);
                if (tid < 465) ((LAS float*)((LAS char*)lds + attn_body::LDS_BIAS))[tid] = bias2[h * 465 + tid]; }
            const float sk = (MODE == 1) ? sink2[h] : -INFINITY;
            attn_body::attn_unit<8, MODE>(QO + qoff, KL + koff, VL + koff, (abf*)(ws + WS_QO) + qoff, Z + qoff, NT, 256 + ltok0, q0, ltok0, sk, lds);
        } else { const int uc = U - 2048, bc = uc >> 4, h = uc & 15, kvh = h >> 2;
            const size_t qoff = ((size_t)bc * 256) * DM + h * 64; const size_t koff = (size_t)bc * 256 * 256 + kvh * 64;
            const float sk = (MODE == 1) ? sink2[h] : -INFINITY;
            attn_body::attn_unit<8, MODE>(QO + qoff, KC + koff, VC + koff, (abf*)(ws + WS_QO) + qoff, Z + qoff, 4, 0, 0, 0, sk, lds);
        }
    }
}

constexpr int N_PHASES = 18;
__global__ void __launch_bounds__(NWAVES * 64, 2) fwd_kernel(Args args) {
    extern __shared__ __attribute__((aligned(16))) unsigned char lds[];
    cg::grid_group grid = cg::this_grid();
    unsigned char* ws = args.ws;
    for (int ph = args.ph_lo; ph < args.ph_hi; ++ph) {
        if (ph == 0) phase_prologue(args, (LAS unsigned char*)lds);
        else if (ph == N_PHASES - 1) phase_rows(args, DEPTH);
        else { const int l = (ph - 1) >> 2, sub = (ph - 1) & 3;
            if (sub == 0) phase_rows(args, l);
            else if (sub == 1) {
                pg8::Gemm g{(const pg8::bf16_t*)(ws + WS_UY), (const pg8::bf16_t*)(ws + WS_WIN) + (size_t)l * INW * DM, MROWS, INW, DM};
                pg8::StaticOrder S; S.init(MROWS, INW, (int)gridDim.x, opq_s((int)blockIdx.x));
                pg8::EpiIn E{(pg8::bf16_t*)(ws + WS_QO), (pg8::bf16_t*)(ws + WS_Z), (pg8::bf16_t*)(ws + WS_KL), (pg8::bf16_t*)(ws + WS_VL), (pg8::bf16_t*)(ws + WS_KC), (pg8::bf16_t*)(ws + WS_VC),
                             args.out + (size_t)MROWS * DM, args.out + (size_t)MROWS * DM + (size_t)16 * DEPTH * 256 * 256,
                             args.in[11] + l * 64, args.in[12] + l * 64, (const float*)(ws + WS_ROPEC), (const float*)(ws + WS_ROPES), (l % 3) != 2, l, attn_body::C2};
                pg8::gemm_phase<pg8::EpiIn, pg8::StaticOrder, PG8_ALIGN, PG8_SP2>((PG8_LAS unsigned char*)lds, g, S, E);
            } else if (sub == 2) {
                const int kind = l % 3;
                if (kind == 0) phase_attn<0>(args, l, (char*)lds); else if (kind == 1) phase_attn<1>(args, l, (char*)lds); else phase_attn<2>(args, l, (char*)lds);
            } else {
                pg8::Gemm g{(const pg8::bf16_t*)(ws + WS_QO), (const pg8::bf16_t*)(ws + WS_WOUT) + (size_t)l * DM * DM, MROWS, DM, DM};
                pg8::StaticOrder S; S.init(MROWS, DM, (int)gridDim.x, opq_s((int)blockIdx.x));
                pg8::EpiOut E{(pg8::bf16_t*)(ws + WS_UY), (float*)(ws + WS_SSQ)};
                pg8::gemm_phase<pg8::EpiOut, pg8::StaticOrder, PG8_ALIGN, PG8_SP2>((PG8_LAS unsigned char*)lds, g, S, E);
            }
        }
        if (ph + 1 < args.ph_hi) grid.sync();
    }
}

#ifndef ONE_LAUNCH
#define ONE_LAUNCH 1
#endif
extern "C" void kernel_launch(void* const* d_in, const int* in_sizes, int n_in, void* d_out, int out_size, void* d_ws, size_t ws_size, hipStream_t stream) {
    static int grid = 0;
    if (grid == 0) {
        if (n_in != 16 || ws_size < WS_END) { fprintf(stderr, "kernel_launch: need 16 inputs and %zu bytes of workspace (got %d, %zu)\n", (size_t)WS_END, n_in, ws_size); grid = -1; return; }
        int dev = 0, cus = 0, per_cu = 0;
        (void)hipGetDevice(&dev); (void)hipDeviceGetAttribute(&cus, hipDeviceAttributeMultiprocessorCount, dev);
        if (hipFuncSetAttribute((const void*)fwd_kernel, hipFuncAttributeMaxDynamicSharedMemorySize, LDS_BYTES) != hipSuccess) { fprintf(stderr, "kernel_launch: hipFuncSetAttribute failed\n"); grid = -1; return; }
        if (hipOccupancyMaxActiveBlocksPerMultiprocessor(&per_cu, (const void*)fwd_kernel, NWAVES * 64, LDS_BYTES) != hipSuccess || per_cu < 1) { fprintf(stderr, "kernel_launch: occupancy query says %d\n", per_cu); per_cu = 1; }
        (void)hipGetLastError();
        grid = cus * per_cu;
    }
    if (grid < 0) return;
    Args a{};
    for (int i = 0; i < 16; ++i) a.in[i] = (const float*)d_in[i];
    a.out = (float*)d_out; a.ws = (unsigned char*)d_ws;
#if ONE_LAUNCH
    a.ph_lo = 0; a.ph_hi = N_PHASES;
    void* kargs[] = {&a};
    hipError_t e = hipLaunchCooperativeKernel((const void*)fwd_kernel, dim3(grid), dim3(NWAVES * 64), kargs, LDS_BYTES, stream);
    if (e != hipSuccess) fprintf(stderr, "cooperative launch failed: %s (grid %d)\n", hipGetErrorString(e), grid);
#else
    for (int ph = 0; ph < N_PHASES; ++ph) { a.ph_lo = ph; a.ph_hi = ph + 1; hipLaunchKernelGGL(fwd_kernel, dim3(grid), dim3(NWAVES * 64), LDS_BYTES, stream, a); }
#endif
}
```

```cpp
#include <hip/hip_runtime.h>
#include <cstdio>
#include <cstdint>
__device__ __forceinline__ int opq_tid(int wave_s) { int l; asm volatile("v_mbcnt_lo_u32_b32 %0, -1, 0\n\tv_mbcnt_hi_u32_b32 %0, -1, %0" : "=v"(l)); return wave_s * 64 + l; }
__device__ __forceinline__ int opq_s(int v) { asm volatile("" : "+s"(v)); return v; }
namespace pg8 {
#define PG8_LAS __attribute__((address_space(3)))
typedef unsigned short bf16_t;
typedef short bf16x8 __attribute__((ext_vector_type(8)));
typedef float f32x4 __attribute__((ext_vector_type(4)));
typedef unsigned u32x4 __attribute__((ext_vector_type(4)));
constexpr int BM = 256, BK = 64, HALF = 128, HTB = HALF * BK * 2  , STAGE_BYTES = 8 * HTB, NXCD = 8, WGM = 8;

__host__ __device__ __forceinline__ int lds_byte(int r, int c) { const int st = (r >> 4) * 2 + (c >> 5), rr = r & 15, cc = c & 31, ob = rr * 64 + cc * 2; return st * 1024 + (ob ^ (((ob >> 9) & 1) << 5)); }
__host__ __device__ __forceinline__ void stage_rc(int b, int& R, int& C) { const int st = b / 1024, sb = b % 1024, swz = sb ^ (((sb >> 9) & 1) << 5); R = (st >> 1) * 16 + swz / 64; C = (st & 1) * 32 + (swz % 64) / 2; }
__host__ __device__ __forceinline__ int perm32(int rho) { const int n = rho >> 4, i = rho & 15; return 8 * (i >> 2) + 4 * n + (i & 3); }

struct Unit { int pm, pn; };
struct Gemm { const bf16_t* A; const bf16_t* Bt; int M, N, K; };

struct StaticOrder {
    int nM, nN, nwg, G, c;
    __host__ __device__ void init(int M, int N, int G_, int c_) { nM = M / BM; nN = N / BM; nwg = nM * nN; G = G_; c = c_; }
    __host__ __device__ bool next(int i, Unit& u) const {
        const long L = (long)i * G + c; if (L >= nwg) return false;
        int wgid = (int)L; { const int q = nwg / NXCD, r = nwg % NXCD, xcd = wgid % NXCD, off = wgid / NXCD; wgid = (xcd < r ? xcd * (q + 1) : r * (q + 1) + (xcd - r) * q) + off; }
        const int nig = WGM * nN, gid = wgid / nig, fm = gid * WGM, gsz = (nM - fm) < WGM ? (nM - fm) : WGM;
        u.pm = fm + ((wgid % nig) % gsz); u.pn = (wgid % nig) / gsz; return true;
    }
    __device__ __forceinline__ void a_ready(const Unit&) const {}
    __device__ __forceinline__ void done(const Unit&) const {}
};

__device__ __forceinline__ unsigned cvt_pk_bf16(float lo, float hi) { unsigned r; asm volatile("v_cvt_pk_bf16_f32 %0, %1, %2" : "=v"(r) : "v"(lo), "v"(hi)); return r; }
typedef float f32x2 __attribute__((ext_vector_type(2)));
__device__ __forceinline__ f32x2 gelu_pk(f32x2 v) {
    const f32x2 av = __builtin_elementwise_abs(v), d = av * 0.2316418882f + 1.0f;
    f32x2 t; t.x = __builtin_amdgcn_rcpf(d.x); t.y = __builtin_amdgcn_rcpf(d.y);
    f32x2 q = t * 0.5307027145f + (-0.7265760135f); q = q * t + 0.7107068705f; q = q * t + (-0.142248368f); q = q * t + 0.127414796f; q = q * t;
    const f32x2 s = (v * v) * (-0.72134752044f);
    f32x2 e; e.x = __builtin_amdgcn_exp2f(s.x); e.y = __builtin_amdgcn_exp2f(s.y);
    const f32x2 m = v * (q * e), r = v - m;
    f32x2 o; o.x = v.x < 0.f ? m.x : r.x; o.y = v.y < 0.f ? m.y : r.y; return o;
}

template <int ACT  > struct EpiBf16 {
    static constexpr bool PERM = true, AFTER_DRAIN = false; static_assert(ACT == 0 || ACT == 1, "EpiBf16: ACT is 0 (none) or 1 (gelu_pk)");
    bf16_t* O; int ldc; const float* bias; int split_cols; size_t split_stride; float scale0;
    __device__ __forceinline__ void operator()(const f32x4 (&acc)[2][2][4][2], const Unit& u, int wr, int wc, int fr, int fq) const {
        const int row0 = u.pm * BM + wr * 64 + fr; int colt = u.pn * BM; bf16_t* base = O;
        float sc = 1.f; if (split_cols) { const int t = colt / split_cols; base += (size_t)t * split_stride; colt -= t * split_cols; if (t == 0) sc = scale0; }
        const int col0 = colt + wc * 32 + 8 * fq, bcol0 = u.pn * BM + wc * 32 + 8 * fq;
        f32x4 bv[2][2];
#pragma unroll
        for (int bj = 0; bj < 2; ++bj)
#pragma unroll
            for (int n = 0; n < 2; ++n) bv[bj][n] = bias ? *(const f32x4*)(bias + bcol0 + bj * HALF + 4 * n) : (f32x4){0.f, 0.f, 0.f, 0.f};
#pragma unroll
        for (int ai = 0; ai < 2; ++ai)
#pragma unroll
            for (int m = 0; m < 4; ++m) { bf16_t* rowp = base + (size_t)(row0 + ai * HALF + m * 16) * ldc + col0;
#pragma unroll
                for (int bj = 0; bj < 2; ++bj) { f32x4 v0 = acc[ai][bj][m][0] + bv[bj][0], v1 = acc[ai][bj][m][1] + bv[bj][1];
                    if (ACT == 1) { f32x2 a = gelu_pk((f32x2){v0[0], v0[1]}), b = gelu_pk((f32x2){v0[2], v0[3]}), c = gelu_pk((f32x2){v1[0], v1[1]}), d = gelu_pk((f32x2){v1[2], v1[3]});
                        v0 = (f32x4){a.x, a.y, b.x, b.y}; v1 = (f32x4){c.x, c.y, d.x, d.y}; }
                    v0 = v0 * sc; v1 = v1 * sc; u32x4 w; w.x = cvt_pk_bf16(v0[0], v0[1]); w.y = cvt_pk_bf16(v0[2], v0[3]); w.z = cvt_pk_bf16(v1[0], v1[1]); w.w = cvt_pk_bf16(v1[2], v1[3]);
                    *(u32x4*)(rowp + bj * HALF) = w; } }
    }
};
__device__ __forceinline__ float silu_f(float x) { return x * __builtin_amdgcn_rcpf(1.0f + __builtin_amdgcn_exp2f(-1.4426950408889634f * x)); }
__device__ __forceinline__ u32x4 pack8(const f32x4 a, const f32x4 b) { u32x4 w; w.x = cvt_pk_bf16(a[0], a[1]); w.y = cvt_pk_bf16(a[2], a[3]); w.z = cvt_pk_bf16(b[0], b[1]); w.w = cvt_pk_bf16(b[2], b[3]); return w; }
constexpr int MCTX = 4096, LROWS = 4352  ;
struct EpiIn {
    static constexpr bool PERM = true, AFTER_DRAIN = false;
    bf16_t *Q, *Z, *KL, *VL, *KC, *VC; float *outK, *outV;
    const float *qg, *kg, *rc, *rs; int rope, layer; float qscale;
    __device__ __forceinline__ void operator()(const f32x4 (&acc)[2][2][4][2], const Unit& u, int wr, int wc, int fr, int fq) const {
        const int pn = u.pn; const bool ctx = u.pm < (MCTX / BM);
        if (pn >= 6) {
#pragma unroll
            for (int ai = 0; ai < 2; ++ai)
#pragma unroll
                for (int m = 0; m < 4; ++m) { const int row = u.pm * BM + ai * HALF + wr * 64 + m * 16 + fr;
                    bf16_t* dst = Z + (size_t)row * 1024 + (pn - 6) * 256 + 64 * wc + 8 * fq;
#pragma unroll
                    for (int bj = 0; bj < 2; ++bj) { f32x4 a = acc[ai][bj][m][0], b = acc[ai][bj][m][1];
#pragma unroll
                        for (int e = 0; e < 4; ++e) { a[e] = silu_f(a[e]); b[e] = silu_f(b[e]); }
                        *(u32x4*)(dst + 32 * bj) = pack8(a, b); } }
        } else if (pn == 5) {
#pragma unroll
            for (int ai = 0; ai < 2; ++ai)
#pragma unroll
                for (int m = 0; m < 4; ++m) { const int row = u.pm * BM + ai * HALF + wr * 64 + m * 16 + fr; const int col = 64 * wc + 8 * fq;
                    if (ctx) { bf16_t* dst = VC + (size_t)row * 256 + col; float* od = outV + ((size_t)((row >> 8) * 4 + layer) * 256 + (row & 255)) * 256 + col;
#pragma unroll
                        for (int bj = 0; bj < 2; ++bj) { *(u32x4*)(dst + 32 * bj) = pack8(acc[ai][bj][m][0], acc[ai][bj][m][1]); *(f32x4*)(od + 32 * bj) = acc[ai][bj][m][0]; *(f32x4*)(od + 32 * bj + 4) = acc[ai][bj][m][1]; }
                    } else { const int ml = row - MCTX; bf16_t* dst = VL + ((size_t)(ml >> 12) * LROWS + 256 + (ml & 4095)) * 256 + col;
#pragma unroll
                        for (int bj = 0; bj < 2; ++bj) *(u32x4*)(dst + 32 * bj) = pack8(acc[ai][bj][m][0], acc[ai][bj][m][1]); } }
        } else {
            const bool isq = pn < 4; const float* gp = (isq ? qg : kg) + 8 * fq;
            const f32x4 g00 = *(const f32x4*)(gp), g01 = *(const f32x4*)(gp + 4), g10 = *(const f32x4*)(gp + 32), g11 = *(const f32x4*)(gp + 36);
            const float sc = isq ? qscale : 1.0f;
#pragma unroll
            for (int ai = 0; ai < 2; ++ai)
#pragma unroll
                for (int m = 0; m < 4; ++m) { const int row = u.pm * BM + ai * HALF + wr * 64 + m * 16 + fr;
                    f32x4 x00 = acc[ai][0][m][0], x01 = acc[ai][0][m][1], x10 = acc[ai][1][m][0], x11 = acc[ai][1][m][1];
                    float ss = 0.f;
#pragma unroll
                    for (int e = 0; e < 4; ++e) ss += x00[e] * x00[e] + x01[e] * x01[e] + x10[e] * x10[e] + x11[e] * x11[e];
                    ss += __shfl_xor(ss, 16); ss += __shfl_xor(ss, 32);
                    const float r = __builtin_amdgcn_rsqf(ss * (1.0f / 64.0f) + 1e-6f);
                    x00 = x00 * r * g00; x01 = x01 * r * g01; x10 = x10 * r * g10; x11 = x11 * r * g11;
                    if (!ctx && rope) { const int t = (row - MCTX) & 4095; const int pos = (fq < 2) ? (t >> 6) : (t & 63); const float* cp = rc + pos * 16 + 8 * (fq & 1); const float* sp = rs + pos * 16 + 8 * (fq & 1);
                        const f32x4 c0 = *(const f32x4*)cp, c1 = *(const f32x4*)(cp + 4), s0 = *(const f32x4*)sp, s1 = *(const f32x4*)(sp + 4);
                        const f32x4 a0 = x00 * c0 - x10 * s0, b0 = x10 * c0 + x00 * s0, a1 = x01 * c1 - x11 * s1, b1 = x11 * c1 + x01 * s1;
                        x00 = a0; x10 = b0; x01 = a1; x11 = b1; }
                    if (isq) { bf16_t* dst = Q + (size_t)row * 1024 + (4 * pn + wc) * 64 + 8 * fq;
                        *(u32x4*)(dst) = pack8(x00 * sc, x01 * sc); *(u32x4*)(dst + 32) = pack8(x10 * sc, x11 * sc);
                    } else if (ctx) { const int col = 64 * wc + 8 * fq; bf16_t* dst = KC + (size_t)row * 256 + col; float* od = outK + ((size_t)((row >> 8) * 4 + layer) * 256 + (row & 255)) * 256 + col;
                        *(u32x4*)(dst) = pack8(x00, x01); *(u32x4*)(dst + 32) = pack8(x10, x11);
                        *(f32x4*)(od) = x00; *(f32x4*)(od + 4) = x01; *(f32x4*)(od + 32) = x10; *(f32x4*)(od + 36) = x11;
                    } else { const int ml = row - MCTX; bf16_t* dst = KL + ((size_t)(ml >> 12) * LROWS + 256 + (ml & 4095)) * 256 + 64 * wc + 8 * fq;
                        *(u32x4*)(dst) = pack8(x00, x01); *(u32x4*)(dst + 32) = pack8(x10, x11); } }
        }
    }
};
struct EpiOut {
    static constexpr bool PERM = true, AFTER_DRAIN = false;
    bf16_t* Y; float* SSQ;
    __device__ __forceinline__ void operator()(const f32x4 (&acc)[2][2][4][2], const Unit& u, int wr, int wc, int fr, int fq) const {
#pragma unroll
        for (int ai = 0; ai < 2; ++ai)
#pragma unroll
            for (int m = 0; m < 4; ++m) { const int row = u.pm * BM + ai * HALF + wr * 64 + m * 16 + fr; bf16_t* dst = Y + (size_t)row * 1024 + u.pn * BM + 32 * wc + 8 * fq; float ss = 0.f;
#pragma unroll
                for (int bj = 0; bj < 2; ++bj) { const f32x4 a = acc[ai][bj][m][0], b = acc[ai][bj][m][1];
#pragma unroll
                    for (int e = 0; e < 4; ++e) ss += a[e] * a[e] + b[e] * b[e];
                    *(u32x4*)(dst + bj * HALF) = pack8(a, b); }
                ss += __shfl_xor(ss, 16); ss += __shfl_xor(ss, 32);
                if (fq == 0) SSQ[(size_t)row * 16 + u.pn * 4 + wc] = ss; }
    }
};

template <class Epi, class Sched, bool ALIGN_EPI = false, bool SP2 = false>
__device__ __forceinline__ void gemm_phase(PG8_LAS unsigned char* lds, const Gemm g, const Sched& S, const Epi& E, const int wave_s) {
    const int tid = opq_tid(wave_s), wid = __builtin_amdgcn_readfirstlane(tid >> 6), lane = tid & 63, wr = wid >> 2, wc = wid & 3, fr = lane & 15, fq = lane >> 4;
    const int K = g.K, nt = K / BK;
    unsigned voffA[2], voffB[2];
#pragma unroll
    for (int i = 0; i < 2; ++i) { int R, C; stage_rc(tid * 16 + i * 8192, R, C); const int Rb = Epi::PERM ? ((R & ~31) + perm32(R & 31)) : R;
        voffA[i] = (unsigned)(R * K + C) * 2u; voffB[i] = (unsigned)(Rb * K + C) * 2u; }
    const size_t kstep = (size_t)(BK * 2);
    const size_t hstep = (size_t)HALF * K * 2;
    const size_t tstep = 2 * hstep;
    const unsigned ldsw = (unsigned)wid * 1024u;
    const int aoff = lds_byte(wr * 64 + fr, fq * 8), boff = lds_byte(wc * 32 + fr, fq * 8);
#define PG8_SA(b, h) (((b) * 2 + (h)) * HTB)
#define PG8_SB(b, h) ((4 + (b) * 2 + (h)) * HTB)
#define PG8_STAGE(bufoff, gbase, voff) do { _Pragma("unroll") for (int _i = 0; _i < 2; ++_i) \
        __builtin_amdgcn_global_load_lds((const unsigned*)((const char*)(gbase) + (voff)[_i]), (PG8_LAS unsigned*)(lds + (bufoff) + ldsw + _i * 8192), 16, 0, 0); } while (0)
#define PG8_LDA(dst, b, h) do { _Pragma("unroll") for (int m = 0; m < 4; ++m) _Pragma("unroll") for (int k = 0; k < 2; ++k) dst[m][k] = *(const PG8_LAS bf16x8*)(lds + PG8_SA(b, h) + aoff + m * 2048 + k * 1024); } while (0)
#define PG8_LDB(dst, b, h) do { _Pragma("unroll") for (int n = 0; n < 2; ++n) _Pragma("unroll") for (int k = 0; k < 2; ++k) dst[n][k] = *(const PG8_LAS bf16x8*)(lds + PG8_SB(b, h) + boff + n * 2048 + k * 1024); } while (0)
#define PG8_MMA(ai, bj, At, Bt) do { __builtin_amdgcn_s_setprio(1); _Pragma("unroll") for (int m = 0; m < 4; ++m) _Pragma("unroll") for (int n = 0; n < 2; ++n) _Pragma("unroll") for (int k = 0; k < 2; ++k) \
        acc[ai][bj][m][n] = __builtin_amdgcn_mfma_f32_16x16x32_bf16(Bt[n][k], At[m][k], acc[ai][bj][m][n], 0, 0, 0); __builtin_amdgcn_s_setprio(0); } while (0)
#define PG8_WAIT_V(n) asm volatile("s_waitcnt vmcnt(" #n ")" ::: "memory")
#define PG8_WAIT_L(n) asm volatile("s_waitcnt lgkmcnt(" #n ")" ::: "memory")
#define PG8_BAR __builtin_amdgcn_s_barrier()
#define PG8_SCHED __builtin_amdgcn_sched_barrier(0)
    Unit cur, nxt; int ui = 0;
    if (!S.next(0, cur)) return;
    f32x4 acc[2][2][4][2];
#pragma unroll
    for (int a = 0; a < 2; ++a)
#pragma unroll
        for (int b = 0; b < 2; ++b)
#pragma unroll
            for (int m = 0; m < 4; ++m)
#pragma unroll
                for (int n = 0; n < 2; ++n) acc[a][b][m][n] = (f32x4){0.f, 0.f, 0.f, 0.f};
    bf16x8 At[4][2], B0[2][2], B1[2][2];
    const char* cA = (const char*)g.A + (size_t)cur.pm * tstep; const char* cB = (const char*)g.Bt + (size_t)cur.pn * tstep;
    S.a_ready(cur);
    if constexpr (SP2) {
        PG8_STAGE(PG8_SB(0, 0), cB, voffB); PG8_STAGE(PG8_SB(0, 1), cB + hstep, voffB); PG8_STAGE(PG8_SA(0, 0), cA, voffA); PG8_STAGE(PG8_SA(0, 1), cA + hstep, voffA);
        if (wr == 1) PG8_BAR;
        PG8_WAIT_V(2); PG8_BAR;
        PG8_STAGE(PG8_SB(1, 0), cB + kstep, voffB); PG8_STAGE(PG8_SA(1, 0), cA + kstep, voffA); PG8_STAGE(PG8_SB(1, 1), cB + hstep + kstep, voffB);
        PG8_WAIT_V(6); PG8_BAR;
    } else {
        PG8_STAGE(PG8_SB(0, 0), cB, voffB); PG8_STAGE(PG8_SA(0, 0), cA, voffA); PG8_STAGE(PG8_SB(0, 1), cB + hstep, voffB); PG8_STAGE(PG8_SA(0, 1), cA + hstep, voffA);
        if (wr == 1) PG8_BAR;
        PG8_WAIT_V(4); PG8_BAR;
        PG8_STAGE(PG8_SB(1, 0), cB + kstep, voffB); PG8_STAGE(PG8_SA(1, 0), cA + kstep, voffA); PG8_STAGE(PG8_SB(1, 1), cB + hstep + kstep, voffB);
        PG8_WAIT_V(6); PG8_BAR;
    }
    for (;;) {
        const bool has_next = S.next(ui + 1, nxt);
        const char* nA = has_next ? (const char*)g.A + (size_t)nxt.pm * tstep : cA; const char* nB = has_next ? (const char*)g.Bt + (size_t)nxt.pn * tstep : cB;
        for (int t = 0; t < nt; t += 2) {
            const bool last = (t == nt - 2);
            const char* a1 = cA + (size_t)(t + 1) * kstep;
            const char* a2 = last ? nA : cA + (size_t)(t + 2) * kstep; const char* b2 = last ? nB : cB + (size_t)(t + 2) * kstep;
            const char* a3 = a2 + kstep; const char* b3 = b2 + kstep;
            if (last && has_next) S.a_ready(nxt);
            if constexpr (SP2) {
            PG8_LDB(B0, 0, 0); PG8_LDB(B1, 0, 1); PG8_SCHED; PG8_LDA(At, 0, 0); PG8_STAGE(PG8_SA(1, 1), a1 + hstep, voffA);
            PG8_WAIT_V(8); PG8_WAIT_L(0); PG8_BAR; PG8_MMA(0, 0, At, B0); PG8_MMA(0, 1, At, B1); PG8_BAR; PG8_SCHED;
            PG8_LDA(At, 0, 1); PG8_STAGE(PG8_SB(0, 0), b2, voffB); PG8_STAGE(PG8_SB(0, 1), b2 + hstep, voffB); PG8_STAGE(PG8_SA(0, 0), a2, voffA);
            PG8_WAIT_V(8); PG8_WAIT_L(0); PG8_BAR; PG8_MMA(1, 0, At, B0); PG8_MMA(1, 1, At, B1); PG8_BAR; PG8_SCHED;
            PG8_LDB(B0, 1, 0); PG8_LDB(B1, 1, 1); PG8_SCHED; PG8_LDA(At, 1, 0); PG8_STAGE(PG8_SA(0, 1), a2 + hstep, voffA);
            PG8_WAIT_V(8); PG8_WAIT_L(0); PG8_BAR; PG8_MMA(0, 0, At, B0); PG8_MMA(0, 1, At, B1); PG8_BAR; PG8_SCHED;
            PG8_LDA(At, 1, 1); PG8_STAGE(PG8_SB(1, 0), b3, voffB); PG8_STAGE(PG8_SB(1, 1), b3 + hstep, voffB); PG8_STAGE(PG8_SA(1, 0), a3, voffA);
            PG8_WAIT_V(8); PG8_WAIT_L(0); PG8_BAR; PG8_MMA(1, 0, At, B0); PG8_MMA(1, 1, At, B1); PG8_BAR; PG8_SCHED;
            } else {
            PG8_LDB(B0, 0, 0); PG8_SCHED; PG8_LDA(At, 0, 0); PG8_STAGE(PG8_SA(1, 1), a1 + hstep, voffA);
            PG8_WAIT_L(8); PG8_BAR; PG8_WAIT_L(0); PG8_MMA(0, 0, At, B0); PG8_BAR; PG8_SCHED;
            PG8_LDB(B1, 0, 1); PG8_STAGE(PG8_SB(0, 0), b2, voffB);
            PG8_BAR; PG8_WAIT_L(0); PG8_MMA(0, 1, At, B1); PG8_BAR;
            PG8_LDA(At, 0, 1); PG8_STAGE(PG8_SA(0, 0), a2, voffA);
            PG8_BAR; PG8_WAIT_L(0); PG8_MMA(1, 0, At, B0); PG8_BAR; PG8_SCHED;
            PG8_STAGE(PG8_SB(0, 1), b2 + hstep, voffB);
            PG8_WAIT_V(6); PG8_BAR; PG8_MMA(1, 1, At, B1); PG8_BAR;
            PG8_LDB(B0, 1, 0); PG8_SCHED; PG8_LDA(At, 1, 0); PG8_STAGE(PG8_SA(0, 1), a2 + hstep, voffA);
            PG8_WAIT_L(8); PG8_BAR; PG8_WAIT_L(0); PG8_MMA(0, 0, At, B0); PG8_BAR; PG8_SCHED;
            PG8_LDB(B1, 1, 1); PG8_STAGE(PG8_SB(1, 0), b3, voffB);
            PG8_BAR; PG8_WAIT_L(0); PG8_MMA(0, 1, At, B1); PG8_BAR;
            PG8_LDA(At, 1, 1); PG8_STAGE(PG8_SA(1, 0), a3, voffA);
            PG8_BAR; PG8_WAIT_L(0); PG8_MMA(1, 0, At, B0); PG8_BAR; PG8_SCHED;
            PG8_STAGE(PG8_SB(1, 1), b3 + hstep, voffB);
            PG8_WAIT_V(6); PG8_BAR; PG8_MMA(1, 1, At, B1); PG8_BAR;
            }
        }
        if constexpr (ALIGN_EPI) { if (wr == 0) PG8_BAR; }
        if constexpr (!Epi::AFTER_DRAIN) { E(acc, cur, wr, wc, fr, fq); S.done(cur); }
        if (!has_next) break;
#pragma unroll
        for (int a = 0; a < 2; ++a)
#pragma unroll
            for (int b = 0; b < 2; ++b)
#pragma unroll
                for (int m = 0; m < 4; ++m)
#pragma unroll
                    for (int n = 0; n < 2; ++n) acc[a][b][m][n] = (f32x4){0.f, 0.f, 0.f, 0.f};
        cur = nxt; cA = nA; cB = nB; ++ui;
        if constexpr (ALIGN_EPI) { if (wr == 1) PG8_BAR; }
    }
    PG8_WAIT_V(0);
    if constexpr (!ALIGN_EPI) { if (wr == 0) PG8_BAR; }
    PG8_BAR;
    if constexpr (Epi::AFTER_DRAIN) { E.fused(acc, cur, wr, wc, fr, fq, lds, wid, lane); S.done(cur); }
#undef PG8_SA
#undef PG8_SB
#undef PG8_STAGE
#undef PG8_LDA
#undef PG8_LDB
#undef PG8_MMA
#undef PG8_WAIT_V
#undef PG8_WAIT_L
#undef PG8_BAR
#undef PG8_SCHED
}
}

#ifndef PG8_SP2
#define PG8_SP2 true
#endif
#ifndef PG8_ALIGN
#define PG8_ALIGN true
#endif
#include <hip/hip_bf16.h>
#include <cmath>
#ifndef ATTN_FIXREF
#define ATTN_FIXREF 1
#endif
namespace attn_body {
using bf16=__hip_bfloat16;
using bf16x8=__attribute__((ext_vector_type(8)))short;
using s16x4=__attribute__((ext_vector_type(4)))short;
using f32x16=__attribute__((ext_vector_type(16)))float;
using u32x4=__attribute__((ext_vector_type(4)))unsigned;
constexpr int NHEAD=16,D=64,DM=NHEAD*D,KP=256;
constexpr int NW=8,QBLK=32,QB=QBLK*NW,KVBLK=64;
constexpr int ATTN_PITCH=DM, ATTN_UNIT_ROWS=QB;
__device__ __forceinline__ int crow(int r,int hi){return (r&3)+8*(r>>2)+4*hi;}
#define SBAR() __builtin_amdgcn_sched_barrier(0)
constexpr int NSLOT=3, SLOTB=8192;
constexpr int LDS_K=0, LDS_V=NSLOT*SLOTB, LDS_WS=2*NSLOT*SLOTB, LDS_OST=LDS_WS+NW*64*4, LDS_BIAS=LDS_OST+NW*4096, LDS_BYTES=LDS_BIAS+2048;
constexpr float C2=0.125f*1.4426950408889634f;
__device__ __forceinline__ void glds16(const void*gsrc,unsigned lds_dst){unsigned keep;
  asm volatile("s_mov_b32 %0, m0\n\ts_mov_b32 m0, %2\n\ts_nop 0\n\tglobal_load_lds_dwordx4 %1, off\n\ts_mov_b32 m0, %0":"=&s"(keep):"v"(gsrc),"s"(lds_dst):"memory");}
__device__ __forceinline__ float max3f(float a,float b,float c){float r;asm("v_max3_f32 %0, %1, %2, %3":"=v"(r):"v"(a),"v"(b),"v"(c));return r;}
__device__ __forceinline__ float max2f(float a,float b){float r;asm("v_max_f32_e32 %0, %1, %2":"=v"(r):"v"(a),"v"(b));return r;}
__device__ __forceinline__ float fadd_s(float a,float b){float r;asm("v_add_f32_e32 %0, %1, %2":"=v"(r):"v"(a),"v"(b));return r;}
__device__ __forceinline__ float fsub_s(float a,float b){float r;asm("v_sub_f32_e32 %0, %1, %2":"=v"(r):"v"(a),"v"(b));return r;}
typedef float f32x2_t __attribute__((ext_vector_type(2))); typedef __bf16 bf16x2_t __attribute__((ext_vector_type(2)));
__device__ __forceinline__ unsigned cvtpk_s(float lo,float hi){f32x2_t v={lo,hi};bf16x2_t b=__builtin_convertvector(v,bf16x2_t);return __builtin_bit_cast(unsigned,b);}
#define WAIT_BAR(N) asm volatile("s_waitcnt vmcnt(" #N ") lgkmcnt(0)\n\ts_barrier":::"memory")

__device__ __forceinline__ void qkt(f32x16&p0,f32x16&p1,const char*Kslot,const bf16x8*qr,const f32x16&negm,int r32,int hi){
  const char*kb=Kslot+hi*1024+r32*16;
  #pragma unroll
  for(int d0=0;d0<4;++d0){
    const bf16x8 b0=*reinterpret_cast<const bf16x8*>(kb+d0*2048);
    const bf16x8 b1=*reinterpret_cast<const bf16x8*>(kb+d0*2048+512);
    if(d0==0){p0=__builtin_amdgcn_mfma_f32_32x32x16_bf16(b0,qr[0],negm,0,0,0);p1=__builtin_amdgcn_mfma_f32_32x32x16_bf16(b1,qr[0],negm,0,0,0);}
    else{p0=__builtin_amdgcn_mfma_f32_32x32x16_bf16(b0,qr[d0],p0,0,0,0);p1=__builtin_amdgcn_mfma_f32_32x32x16_bf16(b1,qr[d0],p1,0,0,0);}}
}
typedef __attribute__((address_space(3))) const char* lds_cptr;
typedef short v4i16_t __attribute__((ext_vector_type(4)));
__device__ __forceinline__ void kload8(bf16x8*kf,lds_cptr kp){
  kf[0]=*(const __attribute__((address_space(3))) bf16x8*)(kp);      kf[1]=*(const __attribute__((address_space(3))) bf16x8*)(kp+512);
  kf[2]=*(const __attribute__((address_space(3))) bf16x8*)(kp+2048); kf[3]=*(const __attribute__((address_space(3))) bf16x8*)(kp+2560);
  kf[4]=*(const __attribute__((address_space(3))) bf16x8*)(kp+4096); kf[5]=*(const __attribute__((address_space(3))) bf16x8*)(kp+4608);
  kf[6]=*(const __attribute__((address_space(3))) bf16x8*)(kp+6144); kf[7]=*(const __attribute__((address_space(3))) bf16x8*)(kp+6656);
}
__device__ __forceinline__ void kload2(bf16x8*kf,lds_cptr kp,int j){ kf[2*j]=*(const __attribute__((address_space(3))) bf16x8*)(kp+j*2048); kf[2*j+1]=*(const __attribute__((address_space(3))) bf16x8*)(kp+j*2048+512); }
__device__ __forceinline__ s16x4 vtr(lds_cptr p){ return __builtin_bit_cast(s16x4,__builtin_amdgcn_ds_read_tr16_b64_v4i16((__attribute__((address_space(3))) v4i16_t*)p)); }
__device__ __forceinline__ float rowmax(const f32x16&p0,const f32x16&p1){
  float a=max3f(p0[0],p0[1],p1[0]),b=max3f(p0[2],p0[3],p1[1]);a=max3f(a,p1[2],p1[3]);
  #pragma unroll
  for(int r=4;r<16;r+=4){a=max3f(a,p0[r],p0[r+1]);b=max3f(b,p0[r+2],p0[r+3]);a=max3f(a,p1[r],p1[r+1]);b=max3f(b,p1[r+2],p1[r+3]);}
  const float m=max2f(a,b);
  auto rr=__builtin_amdgcn_permlane32_swap(__float_as_uint(m),__float_as_uint(m),false,false);
  return max2f(__uint_as_float(rr[0]),__uint_as_float(rr[1]));
}
__device__ __forceinline__ void pv(f32x16*o,int vb,bf16x8 pa0,bf16x8 pa1,bf16x8 pa2,bf16x8 pa3){
  #pragma unroll
  for(int d0=0;d0<2;++d0){s16x4 lo[4],hi[4];
    #pragma unroll
    for(int ks=0;ks<4;++ks){
      asm volatile("ds_read_b64_tr_b16 %0,%1 offset:%c2":"=&v"(lo[ks]):"v"(vb),"i"(d0*4096+ks*1024):"memory");
      asm volatile("ds_read_b64_tr_b16 %0,%1 offset:%c2":"=&v"(hi[ks]):"v"(vb),"i"(d0*4096+ks*1024+512):"memory");}
    asm volatile("s_waitcnt lgkmcnt(0)":::"memory");SBAR();
    #define PK(k) (bf16x8){lo[k][0],lo[k][1],lo[k][2],lo[k][3],hi[k][0],hi[k][1],hi[k][2],hi[k][3]}
    o[d0]=__builtin_amdgcn_mfma_f32_32x32x16_bf16(pa0,PK(0),o[d0],0,0,0);
    o[d0]=__builtin_amdgcn_mfma_f32_32x32x16_bf16(pa1,PK(1),o[d0],0,0,0);
    o[d0]=__builtin_amdgcn_mfma_f32_32x32x16_bf16(pa2,PK(2),o[d0],0,0,0);
    o[d0]=__builtin_amdgcn_mfma_f32_32x32x16_bf16(pa3,PK(3),o[d0],0,0,0);
    #undef PK
  }
}


template<int MODE> __device__ __forceinline__ const f32x16& pick(const f32x16&c,const f32x16&negm){ if constexpr(MODE!=0) return c; else return negm; }
template<int MODE> __device__ __forceinline__ void cinit(f32x16&c0,f32x16&c1,const f32x16&negm,int t,int hi,int qpos,int ltok0,const __attribute__((address_space(3))) float*btab){
  c0=negm; c1=negm;
  if(t>=4){ const float NEG=-INFINITY;
    if constexpr(MODE==1){ const int d0=ltok0+64*(t-4)+4*hi-qpos+128;
      #pragma unroll
      for(int r=0;r<16;++r){ const int d=d0+(r&3)+8*(r>>2); if((unsigned)d>256u)c0[r]=NEG; if((unsigned)(d+32)>256u)c1[r]=NEG; } }
    else { const int rq=qpos>>6,cq=qpos&63; const int rs=min(max(rq-4,0),56),cs=min(max(cq-8,0),48); const int kr=(ltok0>>6)+(t-4);
      const bool rowok=(unsigned)(kr-rs)<8u; const int ib=(kr-rq+7)*31+15-cq;
      #pragma unroll
      for(int r=0;r<16;++r){ const int kc=4*hi+(r&3)+8*(r>>2);
        const bool ok0=rowok&&((unsigned)(kc-cs)<16u), ok1=rowok&&((unsigned)(kc+32-cs)<16u);
        const float b0=btab[ok0?ib+kc:0], b1=btab[ok1?ib+kc+32:0];
        c0[r]=ok0?(negm[r]+b0):NEG; c1[r]=ok1?(negm[r]+b1):NEG; } } }
}
#ifndef ATTN_STORE16
#define ATTN_STORE16(p,v) (*(u32x4*)(p)=(v))
#endif
template<int THRL,int MODE> __device__ __forceinline__ void attn_unit(const bf16*Qu,const bf16*__restrict__ Kh,const bf16*__restrict__ Vh,bf16*Ou,const bf16*Zu,const int NT,const int lrow,const int qtok0,const int ltok0,const float sink2,const float mref,char*shm,const int wave_s){
  const int tid=opq_tid(wave_s),lane=tid&63,r32=lane&31,hi=lane>>5; const int wid=__builtin_amdgcn_readfirstlane(tid>>6);
  const bf16*Qw=Qu+(long)(wid*QBLK)*DM;
  const unsigned lds0=(unsigned)(uintptr_t)shm;
  float*wsf=(float*)(shm+LDS_WS)+wid*64;
  const bf16*ksrc=Kh+(long)lane*KP+wid*8;
  const bf16*vsrc=Vh+(long)(16*(wid&3)+(lane>>2))*KP+(wid>>2)*32+(lane&3)*8;
  const unsigned kdst=lds0+LDS_K+wid*1024, vdst=lds0+LDS_V+wid*1024;
  #define TROW(t) (((t)<4)?64*(t):lrow+64*((t)-4))
  #define DMA_K(t,slot) glds16(ksrc+(long)TROW(t)*KP,(unsigned)__builtin_amdgcn_readfirstlane(kdst+(slot)))
  #define DMA_V(t,slot) glds16(vsrc+(long)TROW(t)*KP,(unsigned)__builtin_amdgcn_readfirstlane(vdst+(slot)))
  const int vb0=(int)(lds0+LDS_V)+((lane>>4)&1)*32+(lane&3)*8+(4*hi+((lane&15)>>2))*64;
  const char*Kbase=shm+LDS_K; bf16x8 kf[8];
  const lds_cptr shm3=(lds_cptr)shm; const lds_cptr kp0=shm3+LDS_K+hi*1024+r32*16; const lds_cptr vp0=shm3+LDS_V+((lane>>4)&1)*32+(lane&3)*8+(4*hi+((lane&15)>>2))*64;
  DMA_K(0,0);DMA_V(0,0);DMA_K(1,SLOTB);
  bf16x8 qr[4];
  #pragma unroll
  for(int d0=0;d0<4;++d0)qr[d0]=*reinterpret_cast<const bf16x8*>(&Qw[(long)r32*DM+d0*16+hi*8]);
  constexpr bool FIXR=(ATTN_FIXREF!=0);
  float mhat=FIXR?mref:0.f,l_reg=0.f;f32x16 o[2];o[0]=f32x16{};o[1]=f32x16{};f32x16 negm; _Pragma("unroll") for(int r=0;r<16;++r)negm[r]=-mhat; asm volatile("":"+v"(negm));
  const int qpos=qtok0+wid*QBLK+r32; const __attribute__((address_space(3))) float* btab=(const __attribute__((address_space(3))) float*)((lds_cptr)shm+LDS_BIAS);
  bool resc=false;
  #define START(P0,P1) do{ if constexpr(!FIXR) { const float rm=rowmax(P0,P1); resc=false; \
      const float dl=rm; mhat=fadd_s(mhat,dl); \
      _Pragma("unroll") for(int r=0;r<16;++r){P0[r]=fsub_s(P0[r],dl);P1[r]=fsub_s(P1[r],dl);} \
      _Pragma("unroll") for(int r=0;r<16;++r)negm[r]=-mhat; asm volatile("":"+v"(negm)); } \
    _Pragma("unroll") for(int r=0;r<16;++r)P0[r]=__builtin_amdgcn_exp2f(P0[r]); }while(0)
  #define RESC() do{ if(!FIXR && resc){ asm volatile("s_waitcnt lgkmcnt(0)":::"memory"); \
      _Pragma("unroll") for(int d_=0;d_<2;++d_) _Pragma("unroll") for(int r=0;r<16;++r)o[d_][r]*=wsf[crow(r,hi)]; } }while(0)
  f32x16 pA0,pA1,pB0,pB1;
  int sl_prev=0,sl_cur=0,sl_next=SLOTB;
  #define ROT() do{sl_prev=sl_cur;sl_cur=sl_next;sl_next=(sl_next==(NSLOT-1)*SLOTB)?0:sl_next+SLOTB;}while(0)
  DMA_K(2,2*SLOTB);
  WAIT_BAR(3);
  qkt(pA0,pA1,Kbase,qr,negm,r32,hi);asm volatile("s_nop 15\n\ts_nop 7":"+v"(pA0),"+v"(pA1));
  START(pA0,pA1);
  _Pragma("unroll") for(int r=0;r<16;++r)pA1[r]=__builtin_amdgcn_exp2f(pA1[r]);
  WAIT_BAR(0);
  DMA_K(3,0);DMA_V(1,SLOTB);
  ROT();
  kload8(kf,kp0+sl_cur);
  WAIT_BAR(2);
  s16x4 vlo[8],vhi[8]; u32x4 pw0,pw1,pw2,pw3;
  #define PKW(P,B) cvtpk_s(P[B],P[B+1])
  #define PAF(k) __builtin_bit_cast(bf16x8,pw##k)
  #define VFR(i) (bf16x8){vlo[i][0],vlo[i][1],vlo[i][2],vlo[i][3],vhi[i][0],vhi[i][1],vhi[i][2],vhi[i][3]}
  #define PIN(x) asm volatile("":"+v"(x))
  #define MX3(a,b,c) __builtin_fmaxf(__builtin_fmaxf((a),(b)),(c))
  #define GAPA(MF,A0,A1,A2,A3,W0,W1,PW) do{ MF; sacc+=A0; sacc+=A1; sacc+=A2; sacc+=A3; PIN(sacc); W0; W1; PIN(PW); SBAR(); }while(0)
  #define EX(v) __builtin_amdgcn_exp2f(v)
  #define GAPB(MF,X,B) do{ MF; X[B]=EX(X[B]); X[B+1]=EX(X[B+1]); X[B+2]=EX(X[B+2]); X[B+3]=EX(X[B+3]); PIN(X); SBAR(); }while(0)
  #define VRD(i) do{ vlo[i]=vtr(vp_+(((i)>>2)*4096+((i)&3)*1024)); vhi[i]=vtr(vp_+(((i)>>2)*4096+((i)&3)*1024+512)); }while(0)
  #define KRD(G,j) do{ if(G){ kload2(kf,kp0+sl_next,j); SBAR(); } }while(0)
  #define STEP(C0,C1,P0,P1,t,GK,GV,GL) do{ if constexpr(MODE!=0){ cinit<MODE>(C0,C1,negm,(t),hi,qpos,ltok0,btab); } SBAR(); \
    const lds_cptr vp_=vp0+sl_prev; \
    VRD(0); SBAR(); float sacc=(P0[0]+P0[1]); \
    GAPA(C0=__builtin_amdgcn_mfma_f32_32x32x16_bf16(kf[0],qr[0],pick<MODE>(C0,negm),0,0,0), P0[2],P0[3],P0[4],P0[5],     pw0[0]=PKW(P0,0), pw0[1]=PKW(P0,2), pw0); \
    VRD(4); SBAR(); GAPA(C1=__builtin_amdgcn_mfma_f32_32x32x16_bf16(kf[1],qr[0],pick<MODE>(C1,negm),0,0,0), P0[6],P0[7],P0[8],P0[9],     pw0[2]=PKW(P0,4), pw0[3]=PKW(P0,6), pw0); \
    VRD(1); SBAR(); GAPA(C0=__builtin_amdgcn_mfma_f32_32x32x16_bf16(kf[2],qr[1],C0,0,0,0),   P0[10],P0[11],P0[12],P0[13], pw1[0]=PKW(P0,8), pw1[1]=PKW(P0,10), pw1); \
    VRD(5); SBAR(); GAPA(C1=__builtin_amdgcn_mfma_f32_32x32x16_bf16(kf[3],qr[1],C1,0,0,0),   P0[14],P0[15],P1[0],P1[1],   pw1[2]=PKW(P0,12),pw1[3]=PKW(P0,14), pw1); \
    VRD(2); SBAR(); GAPA(C0=__builtin_amdgcn_mfma_f32_32x32x16_bf16(kf[4],qr[2],C0,0,0,0),   P1[2],P1[3],P1[4],P1[5],     pw2[0]=PKW(P1,0), pw2[1]=PKW(P1,2), pw2); \
    VRD(6); SBAR(); GAPA(C1=__builtin_amdgcn_mfma_f32_32x32x16_bf16(kf[5],qr[2],C1,0,0,0),   P1[6],P1[7],P1[8],P1[9],     pw2[2]=PKW(P1,4), pw2[3]=PKW(P1,6), pw2); \
    VRD(3); SBAR(); GAPA(C0=__builtin_amdgcn_mfma_f32_32x32x16_bf16(kf[6],qr[3],C0,0,0,0),   P1[10],P1[11],P1[12],P1[13], pw3[0]=PKW(P1,8), pw3[1]=PKW(P1,10), pw3); \
    VRD(7); SBAR(); GAPA(C1=__builtin_amdgcn_mfma_f32_32x32x16_bf16(kf[7],qr[3],C1,0,0,0),   P1[14],P1[15],0.f,0.f,       pw3[2]=PKW(P1,12),pw3[3]=PKW(P1,14), pw3); \
    l_reg+=sacc; \
    if(GK){DMA_K((t)+3,sl_cur);} if(GV){DMA_V((t)+1,sl_next);} \
    if constexpr(!FIXR) { float a=MX3(C0[0],C0[1],C1[0]),b=MX3(C0[2],C0[3],C1[1]); a=MX3(a,C1[2],C1[3]); \
      _Pragma("unroll") for(int r=4;r<16;r+=4){a=MX3(a,C0[r],C0[r+1]);b=MX3(b,C0[r+2],C0[r+3]);a=MX3(a,C1[r],C1[r+1]);b=MX3(b,C1[r+2],C1[r+3]);} \
      float rm=__builtin_fmaxf(a,b); { auto rr=__builtin_amdgcn_permlane32_swap(__float_as_uint(rm),__float_as_uint(rm),false,false); rm=__builtin_fmaxf(__uint_as_float(rr[0]),__uint_as_float(rr[1])); } \
      resc=false; \
      if(__builtin_expect(__any(rm>(float)THRL),0)){ const float dl=__builtin_fmaxf(rm,0.f); mhat+=dl; \
        _Pragma("unroll") for(int r=0;r<16;++r){C0[r]-=dl;C1[r]-=dl;} \
        _Pragma("unroll") for(int r=0;r<16;++r)negm[r]=-mhat; asm volatile("":"+v"(negm)); \
        const float f=__builtin_amdgcn_exp2f(-dl); l_reg*=f; if(hi==0)wsf[r32]=f; resc=true; } } \
    SBAR(); \
    GAPB(o[0]=__builtin_amdgcn_mfma_f32_32x32x16_bf16(PAF(0),VFR(0),o[0],0,0,0), C0,0); \
    GAPB(o[1]=__builtin_amdgcn_mfma_f32_32x32x16_bf16(PAF(0),VFR(4),o[1],0,0,0), C0,4); \
    KRD(GL,0); GAPB(o[0]=__builtin_amdgcn_mfma_f32_32x32x16_bf16(PAF(1),VFR(1),o[0],0,0,0), C0,8); \
    KRD(GL,1); GAPB(o[1]=__builtin_amdgcn_mfma_f32_32x32x16_bf16(PAF(1),VFR(5),o[1],0,0,0), C0,12); \
    KRD(GL,2); GAPB(o[0]=__builtin_amdgcn_mfma_f32_32x32x16_bf16(PAF(2),VFR(2),o[0],0,0,0), C1,0); \
    KRD(GL,3); GAPB(o[1]=__builtin_amdgcn_mfma_f32_32x32x16_bf16(PAF(2),VFR(6),o[1],0,0,0), C1,4); \
    GAPB(o[0]=__builtin_amdgcn_mfma_f32_32x32x16_bf16(PAF(3),VFR(3),o[0],0,0,0), C1,8); \
    GAPB(o[1]=__builtin_amdgcn_mfma_f32_32x32x16_bf16(PAF(3),VFR(7),o[1],0,0,0), C1,12); \
    }while(0)
  int t=1;
  for(;t+5<NT;t+=2){
    STEP(pB0,pB1,pA0,pA1,t,true,true,true);     WAIT_BAR(2); RESC(); ROT();
    STEP(pA0,pA1,pB0,pB1,t+1,true,true,true);   WAIT_BAR(2); RESC(); ROT();
  }
  #define ENDW(tt) do{ if((tt)+3<NT){WAIT_BAR(2);} else if((tt)+2<NT){WAIT_BAR(1);} else {WAIT_BAR(0);} }while(0)
  for(;t+1<NT;t+=2){
    STEP(pB0,pB1,pA0,pA1,t,(t+3<NT),(t+1<NT),(t+1<NT));       ENDW(t);   RESC(); ROT();
    STEP(pA0,pA1,pB0,pB1,t+1,(t+4<NT),(t+2<NT),(t+2<NT));     ENDW(t+1); RESC(); ROT();
  }
  STEP(pB0,pB1,pA0,pA1,NT-1,false,false,false); RESC();
  { float sacc=pB0[0]+pB0[1]; _Pragma("unroll") for(int r=2;r<16;++r)sacc+=pB0[r]; _Pragma("unroll") for(int r=0;r<16;++r)sacc+=pB1[r]; l_reg+=sacc;
    pw0=(u32x4){PKW(pB0,0),PKW(pB0,2),PKW(pB0,4),PKW(pB0,6)};pw1=(u32x4){PKW(pB0,8),PKW(pB0,10),PKW(pB0,12),PKW(pB0,14)};pw2=(u32x4){PKW(pB1,0),PKW(pB1,2),PKW(pB1,4),PKW(pB1,6)};pw3=(u32x4){PKW(pB1,8),PKW(pB1,10),PKW(pB1,12),PKW(pB1,14)};
    SBAR(); pv(o,vb0+sl_cur,PAF(0),PAF(1),PAF(2),PAF(3)); }
  #undef PKW
  #undef PAF
  #undef VFR
  #undef PIN
  #undef MX3
  #undef GAPA
  #undef GAPB
  #undef EX
  #undef VRD
  #undef KRD
  #undef STEP
  #undef ENDW
  {auto rr=__builtin_amdgcn_permlane32_swap(__float_as_uint(l_reg),__float_as_uint(l_reg),false,false);l_reg=__uint_as_float(rr[0])+__uint_as_float(rr[1]);}
  if constexpr(MODE==1) l_reg+=__builtin_amdgcn_exp2f(sink2-mhat);
  if(hi==0)wsf[32+r32]=l_reg;asm volatile("s_waitcnt lgkmcnt(0)":::"memory");
  float rli[16];
  #pragma unroll
  for(int r=0;r<16;++r)rli[r]=__builtin_amdgcn_rcpf(wsf[32+crow(r,hi)]);
  bf16*Ow=Ou+(long)(wid*QBLK)*DM; const bf16*Zw=Zu+(long)(wid*QBLK)*DM;
  { bf16*stg=(bf16*)(shm+LDS_OST)+wid*2048;
    #pragma unroll
    for(int r=0;r<16;++r){const int orow=crow(r,hi);
      #pragma unroll
      for(int d0=0;d0<2;++d0)stg[orow*64+d0*32+r32]=__float2bfloat16(o[d0][r]*rli[r]);}
    asm volatile("s_waitcnt lgkmcnt(0)":::"memory");
    #pragma unroll
    for(int i=0;i<4;++i){const int row=i*8+(lane>>3),ch=lane&7; u32x4 v=*(const u32x4*)(stg+row*64+ch*8); const u32x4 z=*(const u32x4*)(Zw+(long)row*DM+ch*8);
      _Pragma("unroll") for(int e=0;e<4;++e){ const float lo=__uint_as_float(v[e]<<16)*__uint_as_float(z[e]<<16), hi2=__uint_as_float(v[e]&0xffff0000u)*__uint_as_float(z[e]&0xffff0000u); v[e]=cvtpk_s(lo,hi2); }
      ATTN_STORE16(Ow+(long)row*DM+ch*8,v);} }
  asm volatile("s_waitcnt lgkmcnt(0)\n\ts_barrier":::"memory");
  #undef DMA_K
  #undef DMA_V
  #undef TROW
  #undef START
  #undef RESC
  #undef ROT
}
constexpr int ATTN_LDS_BYTES=LDS_BYTES;
#undef SBAR
#undef WAIT_BAR
}
#include <hip/hip_cooperative_groups.h>
namespace cg = cooperative_groups;
#define GAS __attribute__((address_space(1)))
#define LAS __attribute__((address_space(3)))
typedef unsigned short bf16;
typedef unsigned v4u __attribute__((ext_vector_type(4)));
typedef unsigned v2u __attribute__((ext_vector_type(2)));
typedef float f32x4 __attribute__((ext_vector_type(4)));
#define LDS_WAIT() asm volatile("s_waitcnt lgkmcnt(0)" ::: "memory")
__device__ __forceinline__ unsigned f2bf(float f) { unsigned u = __builtin_bit_cast(unsigned, f); return (u + 0x7fffu + ((u >> 16) & 1u)) >> 16; }
__device__ __forceinline__ unsigned pk2(float lo, float hi) { return f2bf(lo) | (f2bf(hi) << 16); }

constexpr int NWAVES = 8;
constexpr int DM = 1024, NCTX = 4096, NLAT = 32768, MROWS = NCTX + NLAT, INW = 2560, DEPTH = 4, LROWS = 4352;
constexpr float EPS = 1e-6f, LOG2E = 1.4426950408889634f;
constexpr size_t MiB = 1u << 20;
constexpr size_t WS_ROPEC = 0, WS_ROPES = 4096, WS_BIAS2 = 8192, WS_SINK2 = 40960, WS_MREF = 41984, WS_BAR = 49152, WS_MOD = 65536;
constexpr size_t WS_WIN = 2 * MiB, WS_WOUT = 22 * MiB, WS_SSQ = 30 * MiB, WS_KC = 33 * MiB, WS_VC = 35 * MiB, WS_KL = 38 * MiB, WS_VL = 56 * MiB;
constexpr size_t WS_UY = 74 * MiB, WS_QO = 146 * MiB, WS_Z = 218 * MiB, WS_END = 290 * MiB;
constexpr int LDS_BYTES = 147456;
static_assert(attn_body::ATTN_LDS_BYTES <= 131072 && pg8::STAGE_BYTES <= 131072, "phase scratch");

__device__ __forceinline__ float wave_sum(float v) {
#pragma unroll
    for (int o = 1; o < 64; o <<= 1) v += __shfl_xor(v, o);
    return v;
}
template <bool PERMW>
__device__ __forceinline__ void p0_transpose_item(const float* W, int K, int N, bf16* WT, LAS float* scr, int item, int lane) {
    const int nblk = N / 32, kb = item / nblk, nb = item % nblk, k0 = 64 * kb, n0 = 32 * nb;
#pragma unroll 8
    for (int i = 0; i < 32; ++i) { const int kk = 2 * i + (lane >> 5); scr[kk * 33 + (lane & 31)] = W[(size_t)(k0 + kk) * N + n0 + (lane & 31)]; }
    LDS_WAIT(); asm volatile("" ::: "memory");
    int r0 = n0;
    if (PERMW) { const int a = n0 & 255; r0 = (n0 & ~255) + 128 * ((a >> 5) & 1) + 32 * (a >> 6); }
    const int c = lane & 7;
#pragma unroll
    for (int j = 0; j < 4; ++j) { const int n = (lane >> 3) + 8 * j; const LAS float* s = scr + (8 * c) * 33 + n;
        v4u o; o.x = pk2(s[0 * 33], s[1 * 33]); o.y = pk2(s[2 * 33], s[3 * 33]); o.z = pk2(s[4 * 33], s[5 * 33]); o.w = pk2(s[6 * 33], s[7 * 33]);
        *(v4u*)(WT + (size_t)(r0 + n) * K + k0 + 8 * c) = o; }
    LDS_WAIT(); asm volatile("" ::: "memory");
}

struct Args { const float* in[16]; float* out; unsigned char* ws; int ph_lo, ph_hi; };

__device__ __forceinline__ void phase_prologue(const Args& A, LAS unsigned char* lds, const int wave_s) {
    const int tid = opq_tid(wave_s), lane = tid & 63, wave = __builtin_amdgcn_readfirstlane(tid >> 6), G = gridDim.x;
    unsigned char* ws = A.ws;
    const float *c = A.in[4], *c_ctx = A.in[5], *w_mod = A.in[6], *b_mod = A.in[7], *w_in = A.in[10], *w_out = A.in[13], *sink = A.in[14], *nab = A.in[15];
    {
        LAS float* scr = (LAS float*)(lds + wave * 16384);
        const int gw = blockIdx.x * NWAVES + wave, NGW = G * NWAVES;
        constexpr int I_IN = (DM / 64) * (INW / 32), I_OUT = (DM / 64) * (DM / 32), NITEMS = DEPTH * (I_IN + I_OUT);
        for (int it = gw; it < NITEMS; it += NGW) {
            if (it < DEPTH * I_IN) { const int l = it / I_IN, r = it % I_IN; p0_transpose_item<true>(w_in + (size_t)l * DM * INW, DM, INW, (bf16*)(ws + WS_WIN) + (size_t)l * INW * DM, scr, r, lane); }
            else { const int q = it - DEPTH * I_IN, l = q / I_OUT, r = q % I_OUT; p0_transpose_item<false>(w_out + (size_t)l * DM * DM, DM, DM, (bf16*)(ws + WS_WOUT) + (size_t)l * DM * DM, scr, r, lane); }
        }
    }
    __syncthreads();
    {
        LAS float* sc = (LAS float*)lds;
        LAS float* red = (LAS float*)(lds + 40960);
        for (int i = tid; i < 9 * 1024; i += NWAVES * 64) { const int j = i >> 10, k = i & 1023; const float v = (j == 0) ? c_ctx[k] : c[(j - 1) * 1024 + k]; sc[i] = v / (1.0f + __expf(-v)); }
        __syncthreads();
        float* MOD = (float*)(ws + WS_MOD);
        const int col = tid & 31, ks = tid >> 5;
        for (int un = blockIdx.x; un < DEPTH * 96; un += G) { const int l = un / 96, n0 = (un % 96) * 32;
            const float* wp = w_mod + ((size_t)l * DM + ks * 64) * 3072 + n0 + col;
            float acc[9];
#pragma unroll
            for (int j = 0; j < 9; ++j) acc[j] = 0.f;
            for (int k4 = 0; k4 < 64; k4 += 4) { const float w0 = wp[(size_t)(k4 + 0) * 3072], w1 = wp[(size_t)(k4 + 1) * 3072], w2 = wp[(size_t)(k4 + 2) * 3072], w3 = wp[(size_t)(k4 + 3) * 3072];
#pragma unroll
                for (int j = 0; j < 9; ++j) { const f32x4 s = *(const LAS f32x4*)(sc + j * 1024 + ks * 64 + k4); acc[j] += s[0] * w0 + s[1] * w1 + s[2] * w2 + s[3] * w3; } }
#pragma unroll
            for (int j = 0; j < 9; ++j) red[(ks * 9 + j) * 32 + col] = acc[j];
            __syncthreads();
            if (tid < 288) { const int j = tid >> 5; float s = b_mod[l * 3072 + n0 + col];
#pragma unroll
                for (int q = 0; q < 16; ++q) s += red[(q * 9 + j) * 32 + col];
                MOD[((size_t)l * 9 + j) * 3072 + n0 + col] = s; }
            __syncthreads();
        }
    }
    if (blockIdx.x == G - 1) {
        float* rc = (float*)(ws + WS_ROPEC); float* rs = (float*)(ws + WS_ROPES); float* b2 = (float*)(ws + WS_BIAS2); float* s2 = (float*)(ws + WS_SINK2);
        for (int i = tid; i < 1024; i += NWAVES * 64) { const int pos = i >> 4, p = i & 15; const float inv = powf(10000.0f, -(float)p / 16.0f); const float ang = (float)pos * inv; rc[i] = cosf(ang); rs[i] = sinf(ang); }
        for (int i = tid; i < 16 * 465; i += NWAVES * 64) b2[i] = nab[i] * LOG2E;
        if (tid < 16) s2[tid] = sink[tid] * LOG2E;
        if (wave == 0) {
            float bm = 0.f; for (int i = lane; i < 16 * 465; i += 64) bm = fmaxf(bm, nab[i] * LOG2E);
#pragma unroll
            for (int o = 1; o < 64; o <<= 1) bm = fmaxf(bm, __shfl_xor(bm, o));
            for (int l = 0; l < DEPTH; ++l) { float mq = fabsf(A.in[11][l * 64 + lane]), mk = fabsf(A.in[12][l * 64 + lane]);
#pragma unroll
                for (int o = 1; o < 64; o <<= 1) { mq = fmaxf(mq, __shfl_xor(mq, o)); mk = fmaxf(mk, __shfl_xor(mk, o)); }
                if (lane == 0) ((float*)(ws + WS_MREF))[l] = 8.0f * LOG2E * mq * mk * 1.01f + 0.05f + ((l % 3) == 2 ? bm : 0.f); } }
    }
}

__device__ __forceinline__ void phase_rows(const Args& A, int l, const int wave_s) {
    const int tid = opq_tid(wave_s), lane = tid & 63, wave = __builtin_amdgcn_readfirstlane(tid >> 6), G = gridDim.x;
    unsigned char* ws = A.ws;
    const float* MOD = (const float*)(ws + WS_MOD);
    const float* norm_pre = A.in[8]; const float* norm_post = A.in[9];
    bf16* UY = (bf16*)(ws + WS_UY); const bf16* YB = (const bf16*)(ws + WS_QO); const float* SSQ = (const float*)(ws + WS_SSQ);
    if (l < DEPTH) {
        const float* ck = A.in[2]; const float* cv = A.in[3]; bf16* KL = (bf16*)(ws + WS_KL); bf16* VL = (bf16*)(ws + WS_VL);
        for (int i = blockIdx.x * (NWAVES * 64) + tid; i < 8 * 256 * 64; i += G * NWAVES * 64) { const int b = i >> 14, r = i & 16383;
            const size_t src = ((size_t)(b * DEPTH + l) * 256 * 256) + (size_t)r * 4, dst = ((size_t)b * LROWS * 256) + (size_t)r * 4;
            const f32x4 k4 = *(const f32x4*)(ck + src), v4 = *(const f32x4*)(cv + src);
            v2u ko, vo; ko.x = pk2(k4[0], k4[1]); ko.y = pk2(k4[2], k4[3]); vo.x = pk2(v4[0], v4[1]); vo.y = pk2(v4[2], v4[3]);
            *(v2u*)(KL + dst) = ko; *(v2u*)(VL + dst) = vo; }
    }
    const int NGW = G * NWAVES, gw = blockIdx.x * NWAVES + wave, RPW = (MROWS + NGW - 1) / NGW;
    int cur = -1; f32x4 gg[4], gp[4], sh[4];
#pragma unroll
    for (int j = 0; j < 4; ++j) { gg[j] = (f32x4){0.f, 0.f, 0.f, 0.f}; gp[j] = gg[j]; sh[j] = gg[j]; }
    for (int i = 0; i < RPW; ++i) { const int row = gw * RPW + i; if (row >= MROWS) break;
        const int bidx = row < NCTX ? 0 : 1 + ((row - NCTX) >> 12);
        if (bidx != cur) { cur = bidx;
#pragma unroll
            for (int j = 0; j < 4; ++j) { const int cidx = lane * 4 + 256 * j;
                if (l > 0) { const f32x4 g = *(const f32x4*)(MOD + ((size_t)(l - 1) * 9 + bidx) * 3072 + 2048 + cidx), p = *(const f32x4*)(norm_post + (l - 1) * DM + cidx); gg[j] = g * p; }
                if (l < DEPTH) { const f32x4 s = *(const f32x4*)(MOD + ((size_t)l * 9 + bidx) * 3072 + 1024 + cidx), p = *(const f32x4*)(norm_pre + l * DM + cidx); gp[j] = p * (s + 1.0f); sh[j] = *(const f32x4*)(MOD + ((size_t)l * 9 + bidx) * 3072 + cidx); } } }
        const float* hsrc = (l <= 1) ? (row < NCTX ? A.in[0] + (size_t)row * DM : A.in[1] + (size_t)(row - NCTX) * DM) : A.out + (size_t)row * DM;
        f32x4 h[4];
#pragma unroll
        for (int j = 0; j < 4; ++j) h[j] = *(const f32x4*)(hsrc + lane * 4 + 256 * j);
        if (l > 0) { v2u y[4];
#pragma unroll
            for (int j = 0; j < 4; ++j) y[j] = *(const v2u*)(YB + (size_t)row * DM + lane * 4 + 256 * j);
            float s = lane < 16 ? SSQ[(size_t)row * 16 + lane] : 0.f; s = wave_sum(s);
            const float r = __builtin_amdgcn_rsqf(s * (1.0f / DM) + EPS);
#pragma unroll
            for (int j = 0; j < 4; ++j) { f32x4 yv; yv[0] = __uint_as_float(y[j].x << 16); yv[1] = __uint_as_float(y[j].x & 0xffff0000u); yv[2] = __uint_as_float(y[j].y << 16); yv[3] = __uint_as_float(y[j].y & 0xffff0000u);
                h[j] = h[j] + gg[j] * (yv * r); *(f32x4*)(A.out + (size_t)row * DM + lane * 4 + 256 * j) = h[j]; } }
        if (l < DEPTH) { float s2 = 0.f;
#pragma unroll
            for (int j = 0; j < 4; ++j) s2 += (h[j][0] * h[j][0] + h[j][1] * h[j][1]) + (h[j][2] * h[j][2] + h[j][3] * h[j][3]);
            s2 = wave_sum(s2); const float r2 = __builtin_amdgcn_rsqf(s2 * (1.0f / DM) + EPS);
#pragma unroll
            for (int j = 0; j < 4; ++j) { const f32x4 uv = h[j] * r2 * gp[j] + sh[j]; v2u o; o.x = pk2(uv[0], uv[1]); o.y = pk2(uv[2], uv[3]); *(v2u*)(UY + (size_t)row * DM + lane * 4 + 256 * j) = o; } }
    }
}

template <int MODE>
__device__ __forceinline__ void phase_attn(const Args& A, int l, char* lds, const int wave_s) {
    using abf = attn_body::bf16;
    unsigned char* ws = A.ws; const int G = gridDim.x, bx = opq_s(blockIdx.x);
    const abf* QO = (const abf*)(ws + WS_QO); const abf* Z = (const abf*)(ws + WS_Z);
    const abf* KL = (const abf*)(ws + WS_KL); const abf* VL = (const abf*)(ws + WS_VL); const abf* KC = (const abf*)(ws + WS_KC); const abf* VC = (const abf*)(ws + WS_VC);
    const float* sink2 = (const float*)(ws + WS_SINK2); const float* bias2 = (const float*)(ws + WS_BIAS2); const float mref = ((const float*)(ws + WS_MREF))[l];
    for (int i = 0;; ++i) {
        int U;
        if (G == 256) { if (i >= 9) break; U = (i < 8) ? ((bx & 7) * 256 + i * 32 + (bx >> 3)) : 2048 + bx; }
        else { U = i * G + bx; if (U >= 2048 + 256) break; }
        if (U < 2048) { const int pair = U >> 6, b = pair >> 2, kvh = pair & 3, h = kvh * 4 + ((U >> 4) & 3), qb = U & 15, q0 = qb * 256;
            const size_t qoff = ((size_t)(NCTX + b * 4096 + q0)) * DM + h * 64; const size_t koff = (size_t)b * LROWS * 256 + kvh * 64;
            int NT, ltok0;
            if (MODE == 0) { NT = 68; ltok0 = 0; }
            else if (MODE == 1) { NT = 12; ltok0 = min(max(q0 - 128, 0), 4096 - 512); }
            else { NT = 16; ltok0 = 64 * min(max(4 * qb - 4, 0), 52);
                const int tid = opq_tid(wave_s); if (tid < 465) ((LAS float*)((LAS char*)lds + attn_body::LDS_BIAS))[tid] = bias2[h * 465 + tid]; }
            const float sk = (MODE == 1) ? sink2[h] : -INFINITY;
            attn_body::attn_unit<8, MODE>(QO + qoff, KL + koff, VL + koff, (abf*)(ws + WS_UY) + qoff, Z + qoff, NT, 256 + ltok0, q0, ltok0, sk, mref, lds, wave_s);
        } else { const int uc = U - 2048, bc = uc >> 4, h = uc & 15, kvh = h >> 2;
            const size_t qoff = ((size_t)bc * 256) * DM + h * 64; const size_t koff = (size_t)bc * 256 * 256 + kvh * 64;
            const float sk = (MODE == 1) ? sink2[h] : -INFINITY;
            attn_body::attn_unit<8, MODE>(QO + qoff, KC + koff, VC + koff, (abf*)(ws + WS_UY) + qoff, Z + qoff, 4, 0, 0, 0, sk, mref, lds, wave_s);
        }
    }
}

__device__ __forceinline__ void grid_bar(unsigned* ctr, unsigned target, int wave_s) {
    asm volatile("s_waitcnt vmcnt(0) lgkmcnt(0)" ::: "memory");
    __syncthreads();
    if (opq_tid(wave_s) == 0) {
        __builtin_amdgcn_fence(__ATOMIC_RELEASE, "agent");
        asm volatile("s_waitcnt vmcnt(0)" ::: "memory");
        __hip_atomic_fetch_add(ctr, 1u, __ATOMIC_RELAXED, __HIP_MEMORY_SCOPE_AGENT);
        while (__hip_atomic_load(ctr, __ATOMIC_RELAXED, __HIP_MEMORY_SCOPE_AGENT) < target) __builtin_amdgcn_s_sleep(1);
        __builtin_amdgcn_fence(__ATOMIC_ACQUIRE, "agent");
        asm volatile("s_waitcnt vmcnt(0)" ::: "memory");
    }
    __syncthreads();
}
constexpr int N_PHASES = 18;
#ifndef PROBE_REP
#define PROBE_REP 0
#endif
__device__ __forceinline__ int probe_reps(int ph) {
    if (PROBE_REP == 0) return 1;
    if (ph == 0) return (PROBE_REP & 1) ? 2 : 1;
    if (ph == N_PHASES - 1) return 1;
    const int l = (ph - 1) >> 2, sub = (ph - 1) & 3;
    if (sub == 0) return (l == 0 && (PROBE_REP & 2)) ? 2 : 1;
    if (sub == 1) return (PROBE_REP & 4) ? 2 : 1;
    if (sub == 2) return ((l % 3) == 0) ? ((PROBE_REP & 8) ? 2 : 1) : ((PROBE_REP & 16) ? 2 : 1);
    return (PROBE_REP & 32) ? 2 : 1;
}
__global__ void __launch_bounds__(NWAVES * 64, 2) fwd_kernel(Args args) {
    extern __shared__ __attribute__((aligned(16))) unsigned char lds[];
    const int wave_s = __builtin_amdgcn_readfirstlane((int)threadIdx.x >> 6);
    if (args.ph_lo < 0) { cg::this_grid().sync(); }
    unsigned char* ws = args.ws;
    for (int ph = args.ph_lo; ph < args.ph_hi; ++ph) {
      for (int rep_ = 0; rep_ < probe_reps(ph); ++rep_) {
        if (ph == 0) phase_prologue(args, (LAS unsigned char*)lds, wave_s);
        else if (ph == N_PHASES - 1) phase_rows(args, DEPTH, wave_s);
        else { const int l = (ph - 1) >> 2, sub = (ph - 1) & 3;
            if (sub == 0) phase_rows(args, l, wave_s);
            else if (sub == 1) {
                pg8::Gemm g{(const pg8::bf16_t*)(ws + WS_UY), (const pg8::bf16_t*)(ws + WS_WIN) + (size_t)l * INW * DM, MROWS, INW, DM};
                pg8::StaticOrder S; S.init(MROWS, INW, (int)gridDim.x, opq_s((int)blockIdx.x));
                pg8::EpiIn E{(pg8::bf16_t*)(ws + WS_QO), (pg8::bf16_t*)(ws + WS_Z), (pg8::bf16_t*)(ws + WS_KL), (pg8::bf16_t*)(ws + WS_VL), (pg8::bf16_t*)(ws + WS_KC), (pg8::bf16_t*)(ws + WS_VC),
                             args.out + (size_t)MROWS * DM, args.out + (size_t)MROWS * DM + (size_t)16 * DEPTH * 256 * 256,
                             args.in[11] + l * 64, args.in[12] + l * 64, (const float*)(ws + WS_ROPEC), (const float*)(ws + WS_ROPES), (l % 3) != 2, l, attn_body::C2};
                pg8::gemm_phase<pg8::EpiIn, pg8::StaticOrder, PG8_ALIGN, PG8_SP2>((PG8_LAS unsigned char*)lds, g, S, E, wave_s);
            } else if (sub == 2) {
                const int kind = l % 3;
                if (kind == 0) phase_attn<0>(args, l, (char*)lds, wave_s); else if (kind == 1) phase_attn<1>(args, l, (char*)lds, wave_s); else phase_attn<2>(args, l, (char*)lds, wave_s);
            } else {
                pg8::Gemm g{(const pg8::bf16_t*)(ws + WS_UY), (const pg8::bf16_t*)(ws + WS_WOUT) + (size_t)l * DM * DM, MROWS, DM, DM};
                pg8::StaticOrder S; S.init(MROWS, DM, (int)gridDim.x, opq_s((int)blockIdx.x));
                pg8::EpiOut E{(pg8::bf16_t*)(ws + WS_QO), (float*)(ws + WS_SSQ)};
                pg8::gemm_phase<pg8::EpiOut, pg8::StaticOrder, PG8_ALIGN, PG8_SP2>((PG8_LAS unsigned char*)lds, g, S, E, wave_s);
            }
        }
      }
        if (ph + 1 < args.ph_hi) grid_bar((unsigned*)(ws + WS_BAR), (unsigned)gridDim.x * (unsigned)(ph - args.ph_lo + 1), wave_s);
    }
}

#ifndef ONE_LAUNCH
#define ONE_LAUNCH 1
#endif
extern "C" void kernel_launch(void* const* d_in, const int* in_sizes, int n_in, void* d_out, int out_size, void* d_ws, size_t ws_size, hipStream_t stream) {
    static int grid = 0;
    if (grid == 0) {
        if (n_in != 16 || ws_size < WS_END) { fprintf(stderr, "kernel_launch: need 16 inputs and %zu bytes of workspace (got %d, %zu)\n", (size_t)WS_END, n_in, ws_size); grid = -1; return; }
        int dev = 0, cus = 0, per_cu = 0;
        (void)hipGetDevice(&dev); (void)hipDeviceGetAttribute(&cus, hipDeviceAttributeMultiprocessorCount, dev);
        if (hipFuncSetAttribute((const void*)fwd_kernel, hipFuncAttributeMaxDynamicSharedMemorySize, LDS_BYTES) != hipSuccess) { fprintf(stderr, "kernel_launch: hipFuncSetAttribute failed\n"); grid = -1; return; }
        if (hipOccupancyMaxActiveBlocksPerMultiprocessor(&per_cu, (const void*)fwd_kernel, NWAVES * 64, LDS_BYTES) != hipSuccess || per_cu < 1) { fprintf(stderr, "kernel_launch: occupancy query says %d\n", per_cu); per_cu = 1; }
        (void)hipGetLastError();
        grid = cus * per_cu;
    }
    if (grid < 0) return;
    Args a{};
    for (int i = 0; i < 16; ++i) a.in[i] = (const float*)d_in[i];
    a.out = (float*)d_out; a.ws = (unsigned char*)d_ws;
#if ONE_LAUNCH
    a.ph_lo = 0; a.ph_hi = N_PHASES;
    if (hipMemsetAsync((unsigned char*)d_ws + WS_BAR, 0, 256, stream) != hipSuccess) { fprintf(stderr, "kernel_launch: memset failed\n"); return; }
    void* kargs[] = {&a};
    hipError_t e = hipLaunchCooperativeKernel((const void*)fwd_kernel, dim3(grid), dim3(NWAVES * 64), kargs, LDS_BYTES, stream);
    if (e != hipSuccess) fprintf(stderr, "cooperative launch failed: %s (grid %d)\n", hipGetErrorString(e), grid);
#else
    for (int ph = 0; ph < N_PHASES; ++ph) { a.ph_lo = ph; a.ph_hi = ph + 1; hipLaunchKernelGGL(fwd_kernel, dim3(grid), dim3(NWAVES * 64), LDS_BYTES, stream, a); }
#endif
}
```
